# Optimizing an MI355X kernel written in HIP

```python
import jax, jax.numpy as jnp
from jax import lax
import numpy as np

D_MODEL = 2048
BATCH = 1
SEQ = 8192
DEPTH = 4
DEC_BATCH = 32
DEC_SEQ = 64
PAST_LEN = 2048

CHUNK = 64
Q_BLOCK = 128
N_MIXERS = 4
GROUP_W = D_MODEL // N_MIXERS
HEAD_DIM = 128
N_HEADS = GROUP_W // HEAD_DIM
D_MIX = N_MIXERS * GROUP_W
D_IN = 12 * GROUP_W
POOL_WINDOWS = (2, 4, 8, 16)
N_POOL = len(POOL_WINDOWS)
POOL_CH = GROUP_W // N_POOL
POOL_PAD = max(POOL_WINDOWS) - 1
D_FF = 4 * D_MODEL
ROPE_BASE = 10000.0
EPS = 1e-6

kernel_name = 'hybrid_stream_ret_sb_pool_hgrn2_step'


def rms_norm(x, g):
    xf = x.astype(jnp.float32)
    y = xf * lax.rsqrt(jnp.mean(xf * xf, axis=-1, keepdims=True) + EPS)
    return (y * g.astype(jnp.float32)).astype(x.dtype)


def rope(x, pos):
    half = HEAD_DIM // 2
    inv = ROPE_BASE ** (-jnp.arange(half, dtype=jnp.float32) / half)
    ang = pos.astype(jnp.float32)[:, None] * inv[None, :]
    cos = jnp.cos(ang)[None, :, None, :]
    sin = jnp.sin(ang)[None, :, None, :]
    x1, x2 = x[..., :half], x[..., half:]
    return jnp.concatenate([x1 * cos - x2 * sin, x1 * sin + x2 * cos], axis=-1).astype(x.dtype)


def split_heads(a):
    return a.reshape(a.shape[0], a.shape[1], N_HEADS, HEAD_DIM)


def to_chunks(a, L):
    B, T, H, D = a.shape
    return a.reshape(B, T // L, L, H, D).transpose(1, 0, 3, 2, 4)


def from_chunks(a):
    n, B, H, L, D = a.shape
    return a.transpose(1, 0, 3, 2, 4).reshape(B, n * L, H, D)


def retention(q, k, v, state):
    f32 = jnp.float32
    T = q.shape[1]
    L = min(T, CHUNK)
    log_gamma = jnp.log(1.0 - 2.0 ** (-5.0 - jnp.arange(N_HEADS, dtype=f32)))
    idx = jnp.arange(L, dtype=f32)
    diff = idx[:, None] - idx[None, :]
    intra = jnp.where(diff >= 0, jnp.exp(jnp.maximum(diff, 0.0)[None] * log_gamma[:, None, None]), 0.0)
    q_dec = jnp.exp((idx + 1.0)[None, :] * log_gamma[:, None])[None, :, :, None]
    k_dec = jnp.exp((L - 1.0 - idx)[None, :] * log_gamma[:, None])[None, :, :, None]
    c_dec = jnp.exp(L * log_gamma)[None, :, None, None]
    qc, kc, vc = (to_chunks(a.astype(f32), L) for a in (q, k, v))

    def step(S, blk):
        qi, ki, vi = blk
        scores = jnp.einsum('bhld,bhmd->bhlm', qi, ki) * intra
        o = jnp.einsum('bhlm,bhme->bhle', scores, vi) + jnp.einsum('bhld,bhde->bhle', qi * q_dec, S)
        S = c_dec * S + jnp.einsum('bhld,bhle->bhde', ki * k_dec, vi)
        return S, o

    S, o = lax.scan(step, state.astype(f32), (qc, kc, vc))
    return from_chunks(o), S


def hgrn2(q, f_logit, i, lb, state):
    f32 = jnp.float32
    T = q.shape[1]
    L = min(T, CHUNK)
    fl = f_logit.astype(f32)
    lbh = lb.reshape(N_HEADS, HEAD_DIM)
    log_f = jnp.logaddexp(jnp.log(lbh), jnp.log1p(-lbh) + jax.nn.log_sigmoid(fl))
    k = (1.0 - lbh) * jax.nn.sigmoid(-fl)
    causal = jnp.tril(jnp.ones((L, L), dtype=bool))[None, None, :, :, None]
    qc, kc, vc, gc = (to_chunks(a, L) for a in (q.astype(f32), k, i.astype(f32), log_f))

    def step(S, blk):
        qi, ki, vi, gi = blk
        G = jnp.cumsum(gi, axis=2)
        rel = jnp.where(causal, G[:, :, :, None, :] - G[:, :, None, :, :], -jnp.inf)
        scores = jnp.einsum('bhld,bhmd,bhlmd->bhlm', qi, ki, jnp.exp(rel))
        o = jnp.einsum('bhlm,bhme->bhle', scores, vi) + jnp.einsum('bhld,bhde->bhle', qi * jnp.exp(G), S)
        G_last = G[:, :, -1:, :]
        S = jnp.exp(G_last[:, :, 0, :])[..., None] * S + jnp.einsum('bhld,bhle->bhde', ki * jnp.exp(G_last - G), vi)
        return S, o

    S, o = lax.scan(step, state.astype(f32), (qc, kc, vc, gc))
    return from_chunks(o), S


def sb_block(q, k, v, q_pos, k_pos):
    z = jnp.einsum('bqhd,bkhd->bhqk', q, k) * (HEAD_DIM ** -0.5)
    valid = (k_pos[None, :] < q_pos[:, None])[None, None]
    log_fail = jnp.where(valid, jax.nn.log_sigmoid(-z), 0.0)
    later = lax.cumsum(log_fail, axis=3, reverse=True) - log_fail
    A = jnp.where(valid, jnp.exp(jax.nn.log_sigmoid(z) + later), 0.0)
    return jnp.einsum('bhqk,bkhd->bqhd', A, v)


def stick_breaking(q, k, v, q_pos, k_pos):
    f32 = jnp.float32
    q, k, v = q.astype(f32), k.astype(f32), v.astype(f32)
    B, T, H, D = q.shape
    if T <= Q_BLOCK:
        return sb_block(q, k, v, q_pos, k_pos)
    nb = T // Q_BLOCK
    qb = q.reshape(B, nb, Q_BLOCK, H, D).transpose(1, 0, 2, 3, 4)
    pb = q_pos.reshape(nb, Q_BLOCK)
    o = lax.map(lambda blk: sb_block(blk[0], k, v, blk[1], k_pos), (qb, pb))
    return o.transpose(1, 0, 2, 3, 4).reshape(B, T, H, D)


def multi_pool(u_ext, pos, pool_w, pool_scale):
    B, Te, C = u_ext.shape
    T = Te - POOL_PAD
    uf = u_ext.astype(jnp.float32)
    cs = jnp.concatenate([jnp.zeros((B, 1, C), jnp.float32), jnp.cumsum(uf, axis=1)], axis=1)
    end = cs[:, POOL_PAD + 1:POOL_PAD + 1 + T]
    tok = uf[:, POOL_PAD:]
    outs = []
    for gi, w in enumerate(POOL_WINDOWS):
        sl = slice(gi * POOL_CH, (gi + 1) * POOL_CH)
        start = cs[:, POOL_PAD + 1 - w:POOL_PAD + 1 - w + T, sl]
        cnt = jnp.minimum(pos + 1, w).astype(jnp.float32)[None, :, None]
        outs.append((end[..., sl] - start) / cnt - tok[..., sl])
    p = jnp.stack(outs, axis=2)
    y = jnp.einsum('btgc,gcd->btgd', p, pool_w.astype(jnp.float32)) * pool_scale.reshape(N_POOL, POOL_CH).astype(jnp.float32)
    return y.reshape(B, T, C).astype(u_ext.dtype)


def token_mixers(h, pos, ret_s, sb_k_past, sb_v_past, pool_s, hg_s, w_in, ret_g, pool_w, pool_scale, lb, hg_g):
    B, T, _ = h.shape
    dt = h.dtype
    z = h @ w_in
    r_q, r_k, r_v, r_g, s_q, s_k, s_v, p_u, g_q, g_f, g_i, g_g = jnp.split(z, 12, axis=-1)
    rq = rope(split_heads(r_q), pos)
    rk = rope(split_heads(r_k), pos) * (HEAD_DIM ** -0.5)
    ro, ret_new = retention(rq, rk, split_heads(r_v), ret_s)
    ro = rms_norm(ro.astype(dt), ret_g.reshape(N_HEADS, HEAD_DIM)).reshape(B, T, GROUP_W) * jax.nn.silu(r_g)
    sk, sv = split_heads(s_k), split_heads(s_v)
    k_all = jnp.concatenate([sb_k_past, sk], axis=1)
    v_all = jnp.concatenate([sb_v_past, sv], axis=1)
    k_pos = jnp.arange(k_all.shape[1], dtype=jnp.int32)
    so = stick_breaking(split_heads(s_q), k_all, v_all, pos, k_pos).astype(dt).reshape(B, T, GROUP_W)
    u_ext = jnp.concatenate([pool_s, p_u], axis=1)
    po = multi_pool(u_ext, pos, pool_w, pool_scale)
    pool_new = u_ext[:, -POOL_PAD:]
    ho, hg_new = hgrn2(jax.nn.silu(split_heads(g_q)), split_heads(g_f), split_heads(g_i), lb, hg_s)
    ho = rms_norm(ho.astype(dt), hg_g.reshape(N_HEADS, HEAD_DIM)).reshape(B, T, GROUP_W) * jax.nn.sigmoid(g_g)
    mix = jnp.concatenate([ro, so, po, ho], axis=-1)
    return mix, (ret_new.astype(dt), sk, sv, pool_new, hg_new.astype(dt))


def run_trunk(x, pos, ret_s, sb_k, sb_v, pool_s, hg_s, norm1_g, w_in, ret_norm_g, pool_w, pool_scale,
              lb_all, hg_norm_g, w_out, norm2_g, w_up, w_down, final_norm_g):
    rets, ks, vs, pools, hgs = [], [], [], [], []
    for l in range(DEPTH):
        h = rms_norm(x, norm1_g[l])
        mix, st = token_mixers(h, pos, ret_s[l], sb_k[l], sb_v[l], pool_s[l], hg_s[l], w_in[l],
                               ret_norm_g[l], pool_w[l], pool_scale[l], lb_all[l], hg_norm_g[l])
        x = x + mix @ w_out[l]
        h = rms_norm(x, norm2_g[l])
        x = x + jnp.square(jax.nn.relu(h @ w_up[l])) @ w_down[l]
        rets.append(st[0]); ks.append(st[1]); vs.append(st[2]); pools.append(st[3]); hgs.append(st[4])
    y = rms_norm(x, final_norm_g)
    return y, jnp.stack(rets), jnp.stack(ks), jnp.stack(vs), jnp.stack(pools), jnp.stack(hgs)


def setup_inputs(seed: int = 0) -> dict:
    key = jax.random.key(seed)
    ks = jax.random.split(key, 20)
    f32 = jnp.float32

    def nrm(k, shape, s):
        return jax.random.normal(k, shape, f32) * s

    return {
        'x_prompt': nrm(ks[0], (BATCH, SEQ, D_MODEL), 1.0),
        'x_sample': nrm(ks[1], (DEC_BATCH, DEC_SEQ, D_MODEL), 1.0),
        'state_ret': nrm(ks[2], (DEPTH, DEC_BATCH, N_HEADS, HEAD_DIM, HEAD_DIM), 0.3),
        'cache_sb_k': nrm(ks[3], (DEPTH, DEC_BATCH, PAST_LEN, N_HEADS, HEAD_DIM), 1.0),
        'cache_sb_v': nrm(ks[4], (DEPTH, DEC_BATCH, PAST_LEN, N_HEADS, HEAD_DIM), 1.0),
        'state_pool': nrm(ks[5], (DEPTH, DEC_BATCH, POOL_PAD, GROUP_W), 1.0),
        'state_hgrn': nrm(ks[6], (DEPTH, DEC_BATCH, N_HEADS, HEAD_DIM, HEAD_DIM), 0.5),
        'norm1_g': 1.0 + nrm(ks[7], (DEPTH, D_MODEL), 0.02),
        'w_in': nrm(ks[8], (DEPTH, D_MODEL, D_IN), D_MODEL ** -0.5),
        'ret_norm_g': 1.0 + nrm(ks[9], (DEPTH, GROUP_W), 0.02),
        'pool_w': nrm(ks[10], (DEPTH, N_POOL, POOL_CH, POOL_CH), POOL_CH ** -0.5),
        'pool_scale': 1.0 + nrm(ks[11], (DEPTH, GROUP_W), 0.02),
        'hg_lower_bounds': nrm(ks[12], (DEPTH, GROUP_W), 0.1),
        'hg_norm_g': 1.0 + nrm(ks[13], (DEPTH, GROUP_W), 0.02),
        'w_out': nrm(ks[14], (DEPTH, D_MIX, D_MODEL), D_MIX ** -0.5),
        'norm2_g': 1.0 + nrm(ks[15], (DEPTH, D_MODEL), 0.02),
        'w_up': nrm(ks[16], (DEPTH, D_MODEL, D_FF), D_MODEL ** -0.5),
        'w_down': nrm(ks[17], (DEPTH, D_FF, D_MODEL), D_FF ** -0.5),
        'final_norm_g': 1.0 + nrm(ks[18], (D_MODEL,), 0.02),
    }


def reference(x_prompt, x_sample, state_ret, cache_sb_k, cache_sb_v, state_pool, state_hgrn,
              norm1_g, w_in, ret_norm_g, pool_w, pool_scale, hg_lower_bounds, hg_norm_g,
              w_out, norm2_g, w_up, w_down, final_norm_g):
    lb_all = jnp.cumsum(jax.nn.softmax(hg_lower_bounds.astype(jnp.float32), axis=0), axis=0)
    lb_all = lb_all - lb_all[0:1]
    dt = x_prompt.dtype
    b_p, t_p = x_prompt.shape[0], x_prompt.shape[1]
    t_s = x_sample.shape[1]
    past = cache_sb_k.shape[2]
    zero_state = jnp.zeros((DEPTH, b_p, N_HEADS, HEAD_DIM, HEAD_DIM), dt)
    empty_kv = jnp.zeros((DEPTH, b_p, 0, N_HEADS, HEAD_DIM), dt)
    zero_pool = jnp.zeros((DEPTH, b_p, POOL_PAD, GROUP_W), dt)
    pos_p = jnp.arange(t_p, dtype=jnp.int32)
    pos_s = past + jnp.arange(t_s, dtype=jnp.int32)
    y_prompt, ret_prompt, sbk_prompt, sbv_prompt, pool_prompt, hgrn_prompt = run_trunk(
        x_prompt, pos_p, zero_state, empty_kv, empty_kv, zero_pool, zero_state,
        norm1_g, w_in, ret_norm_g, pool_w, pool_scale, lb_all, hg_norm_g, w_out, norm2_g, w_up, w_down, final_norm_g)
    y_sample, ret_sample, sbk_sample, sbv_sample, pool_sample, hgrn_sample = run_trunk(
        x_sample, pos_s, state_ret, cache_sb_k, cache_sb_v, state_pool, state_hgrn,
        norm1_g, w_in, ret_norm_g, pool_w, pool_scale, lb_all, hg_norm_g, w_out, norm2_g, w_up, w_down, final_norm_g)
    return (y_prompt, y_sample, ret_prompt, ret_sample, sbk_prompt, sbv_prompt, sbk_sample, sbv_sample,
            pool_prompt, pool_sample, hgrn_prompt, hgrn_sample)
```

```cpp
#include <hip/hip_runtime.h>
#include <cstdio>
#include <cstdint>
#ifndef MK_PER_PHASE
#define MK_PER_PHASE 0
#endif
namespace pg8 {
#define PG8_LAS __attribute__((address_space(3)))
typedef unsigned short bf16_t;
typedef short bf16x8 __attribute__((ext_vector_type(8)));
typedef float f32x4 __attribute__((ext_vector_type(4)));
typedef unsigned u32x4 __attribute__((ext_vector_type(4)));
constexpr int BM = 256, BK = 64, HALF = 128, HTB = HALF * BK * 2  , STAGE_BYTES = 8 * HTB, NXCD = 8, WGM = 8;

__host__ __device__ __forceinline__ int lds_byte(int r, int c) { const int st = (r >> 4) * 2 + (c >> 5), rr = r & 15, cc = c & 31, ob = rr * 64 + cc * 2; return st * 1024 + (ob ^ (((ob >> 9) & 1) << 5)); }
__host__ __device__ __forceinline__ void stage_rc(int b, int& R, int& C) { const int st = b / 1024, sb = b % 1024, swz = sb ^ (((sb >> 9) & 1) << 5); R = (st >> 1) * 16 + swz / 64; C = (st & 1) * 32 + (swz % 64) / 2; }
__host__ __device__ __forceinline__ int perm32(int rho) { const int n = rho >> 4, i = rho & 15; return 8 * (i >> 2) + 4 * n + (i & 3); }

struct Unit { int pm, pn, koff, nt, part; };
struct Gemm { const bf16_t* A; const bf16_t* Bt; int M, N, K; };

struct StaticOrder {
    int nM, nN, nwg, G, c, ntk, wgm;
    __host__ __device__ void init(int M, int N, int G_, int c_, int K_, int wgm_ = WGM) { nM = M / BM; nN = N / BM; nwg = nM * nN; G = G_; c = c_; ntk = K_ / BK; wgm = wgm_; }
    __host__ __device__ void tile_of(int L, Unit& u) const {
        int wgid = L; { const int q = nwg / NXCD, r = nwg % NXCD, xcd = wgid % NXCD, off = wgid / NXCD; wgid = (xcd < r ? xcd * (q + 1) : r * (q + 1) + (xcd - r) * q) + off; }
        const int nig = wgm * nN, gid = wgid / nig, fm = gid * wgm, gsz = (nM - fm) < wgm ? (nM - fm) : wgm;
        u.pm = fm + ((wgid % nig) % gsz); u.pn = (wgid % nig) / gsz; }
    __host__ __device__ bool next(int i, Unit& u) const {
        const long L = (long)i * G + c; if (L >= nwg) return false;
        int wgid = (int)L; { const int q = nwg / NXCD, r = nwg % NXCD, xcd = wgid % NXCD, off = wgid / NXCD; wgid = (xcd < r ? xcd * (q + 1) : r * (q + 1) + (xcd - r) * q) + off; }
        const int nig = wgm * nN, gid = wgid / nig, fm = gid * wgm, gsz = (nM - fm) < wgm ? (nM - fm) : wgm;
        u.pm = fm + ((wgid % nig) % gsz); u.pn = (wgid % nig) / gsz; u.koff = 0; u.nt = ntk; u.part = -1; return true;
    }
    __device__ __forceinline__ void a_ready(const Unit&) const {}
    __device__ __forceinline__ void done(const Unit&) const {}
};
struct SameTileOrder : StaticOrder {
    int nun;
    __host__ __device__ bool next(int i, Unit& u) const { if (i >= nun) return false; u.pm = 0; u.pn = 0; u.koff = 0; u.nt = ntk; u.part = -1; return true; }
};
struct SplitOrder : StaticOrder {
    __host__ __device__ bool next(int i, Unit& u) const {
        if (i == 0) { tile_of(c, u); u.koff = 0; u.nt = ntk; u.part = -1; return true; }
        if (i == 1) { tile_of(G + (c >> 2), u); u.nt = ntk / 4; u.koff = (c & 3) * (ntk / 4) * BK * 2; u.part = c & 3; return true; }
        return false;
    }
};

__device__ __forceinline__ unsigned cvt_pk_bf16(float lo, float hi) { unsigned r; asm volatile("v_cvt_pk_bf16_f32 %0, %1, %2" : "=v"(r) : "v"(lo), "v"(hi)); return r; }
typedef float f32x2 __attribute__((ext_vector_type(2)));
typedef __bf16 bf16x2_t __attribute__((ext_vector_type(2)));
__device__ __forceinline__ unsigned pk2(float a, float b) { f32x2 v = {a, b}; bf16x2_t r = __builtin_convertvector(v, bf16x2_t); return __builtin_bit_cast(unsigned, r); }

struct EpiIn {
    static constexpr bool PERM = true, AFTER_DRAIN = false;
    bf16_t* Z; const float* ssq;
    float* pool_p; float* pool_s;
    __device__ __forceinline__ void operator()(const f32x4 (&acc)[2][2][4][2], const Unit& u, int wr, int wc, int fr, int fq) const {
        asm volatile("" : "+v"(fr), "+v"(fq));
        const int row0 = u.pm * BM + wr * 64 + fr, grp = u.pn >> 1;
        const int col0 = u.pn * BM + wc * 32 + 8 * fq, cg0 = (u.pn & 1) * 256 + wc * 32 + 8 * fq;
#pragma unroll
        for (int ai = 0; ai < 2; ++ai)
#pragma unroll
            for (int m = 0; m < 4; ++m) {
                const int row = row0 + ai * HALF + m * 16;
                float sq; { const f32x4 p0 = *(const f32x4*)(ssq + (size_t)row * 32 + 8 * fq), p1 = *(const f32x4*)(ssq + (size_t)row * 32 + 8 * fq + 4);
                    sq = ((p0[0] + p0[1]) + (p0[2] + p0[3])) + ((p1[0] + p1[1]) + (p1[2] + p1[3])); sq += __shfl_xor(sq, 16); sq += __shfl_xor(sq, 32); }
                const float rs = __builtin_amdgcn_rsqf(sq * (1.0f / 2048.0f) + 1e-6f);
                bf16_t* rowp = Z + (size_t)row * 6144 + col0;
#pragma unroll
                for (int bj = 0; bj < 2; ++bj) {
                    const f32x4 v0 = acc[ai][bj][m][0] * rs, v1 = acc[ai][bj][m][1] * rs;
                    u32x4 w; w.x = pk2(v0[0], v0[1]); w.y = pk2(v0[2], v0[3]); w.z = pk2(v1[0], v1[1]); w.w = pk2(v1[2], v1[3]);
                    *(u32x4*)(rowp + bj * HALF) = w;
                    const int cg = cg0 + bj * HALF;
                    if (grp == 7) {
                        if (u.pm < 32) { if (row >= 8177) { float* dst = pool_p + (size_t)(row - 8177) * 512 + cg; *(f32x4*)(dst) = v0; *(f32x4*)(dst + 4) = v1; } }
                        else { const int rsx = row - 8192, i = rsx & 63; if (i >= 49) { float* dst = pool_s + ((size_t)(rsx >> 6) * 15 + (i - 49)) * 512 + cg; *(f32x4*)(dst) = v0; *(f32x4*)(dst + 4) = v1; } }
                    }
                }
            }
    }
};
struct EpiRes {
    static constexpr bool PERM = true, AFTER_DRAIN = false;
    bf16_t* XB; float* ssq; bf16_t* slab; int slab_id;
    __device__ __forceinline__ void operator()(const f32x4 (&acc)[2][2][4][2], const Unit& u, int wr, int wc, int fr, int fq) const {
        asm volatile("" : "+v"(fr), "+v"(fq));
        if (u.part >= 0) {
            bf16_t* sp = slab + ((size_t)(slab_id * 4 + u.part) * 256 + wr * 64 + fr) * 256 + wc * 32 + 8 * fq;
#pragma unroll
            for (int ai = 0; ai < 2; ++ai)
#pragma unroll
                for (int m = 0; m < 4; ++m)
#pragma unroll
                    for (int bj = 0; bj < 2; ++bj) { const f32x4 a0 = acc[ai][bj][m][0], a1 = acc[ai][bj][m][1];
                        u32x4 w; w.x = pk2(a0[0], a0[1]); w.y = pk2(a0[2], a0[3]); w.z = pk2(a1[0], a1[1]); w.w = pk2(a1[2], a1[3]);
                        *(u32x4*)(sp + (size_t)(ai * HALF + m * 16) * 256 + bj * HALF) = w; }
            return;
        }
        const int row0 = u.pm * BM + wr * 64 + fr, col0 = u.pn * BM + wc * 32 + 8 * fq;
        u32x4 rc[2], rn[2];
        {   const size_t off = (size_t)row0 * 2048 + col0;
#pragma unroll
            for (int bj = 0; bj < 2; ++bj) rc[bj] = *(const u32x4*)(XB + off + bj * HALF); }
#pragma unroll
        for (int ai = 0; ai < 2; ++ai)
#pragma unroll
            for (int m = 0; m < 4; ++m) {
                const int row = row0 + ai * HALF + m * 16; const size_t off = (size_t)row * 2048 + col0; float s = 0.f;
                if (ai * 4 + m < 7) { const int g1 = ai * 4 + m + 1; const size_t offn = (size_t)(row0 + (g1 >> 2) * HALF + (g1 & 3) * 16) * 2048 + col0;
#pragma unroll
                    for (int bj = 0; bj < 2; ++bj) rn[bj] = *(const u32x4*)(XB + offn + bj * HALF); }
#pragma unroll
                for (int bj = 0; bj < 2; ++bj) {
                    const u32x4 r = rc[bj];
                    const f32x4 r0 = {__uint_as_float(r.x << 16), __uint_as_float(r.x & 0xffff0000u), __uint_as_float(r.y << 16), __uint_as_float(r.y & 0xffff0000u)};
                    const f32x4 r1 = {__uint_as_float(r.z << 16), __uint_as_float(r.z & 0xffff0000u), __uint_as_float(r.w << 16), __uint_as_float(r.w & 0xffff0000u)};
                    const f32x4 o0 = r0 + acc[ai][bj][m][0], o1 = r1 + acc[ai][bj][m][1];
                    s += ((o0[0] * o0[0] + o0[1] * o0[1]) + (o0[2] * o0[2] + o0[3] * o0[3])) + ((o1[0] * o1[0] + o1[1] * o1[1]) + (o1[2] * o1[2] + o1[3] * o1[3]));
                    u32x4 w; w.x = pk2(o0[0], o0[1]); w.y = pk2(o0[2], o0[3]); w.z = pk2(o1[0], o1[1]); w.w = pk2(o1[2], o1[3]);
                    *(u32x4*)(XB + off + bj * HALF) = w;
                }
                s += __shfl_xor(s, 16); s += __shfl_xor(s, 32);
                if (fq == 0) ssq[(size_t)row * 32 + u.pn * 4 + wc] = s;
#pragma unroll
                for (int bj = 0; bj < 2; ++bj) rc[bj] = rn[bj];
            }
    }
};
template <int PM = 0> struct EpiUpT {
    static constexpr bool PERM = true, AFTER_DRAIN = false;
    bf16_t* U; const float* ssq; int ldc;
    __device__ __forceinline__ void operator()(const f32x4 (&acc)[2][2][4][2], const Unit& u, int wr, int wc, int fr, int fq) const {
        asm volatile("" : "+v"(fr), "+v"(fq));
        const int row0 = u.pm * BM + wr * 64 + fr, col0 = u.pn * BM + wc * 32 + 8 * fq;
#pragma unroll
        for (int ai = 0; ai < 2; ++ai)
#pragma unroll
            for (int m = 0; m < 4; ++m) {
                const int row = row0 + ai * HALF + m * 16;
                float sq = 2048.f; if (!(PM & 1)) { const f32x4 p0 = *(const f32x4*)(ssq + (size_t)row * 32 + 8 * fq), p1 = *(const f32x4*)(ssq + (size_t)row * 32 + 8 * fq + 4);
                    sq = ((p0[0] + p0[1]) + (p0[2] + p0[3])) + ((p1[0] + p1[1]) + (p1[2] + p1[3])); sq += __shfl_xor(sq, 16); sq += __shfl_xor(sq, 32); }
                float rs = __builtin_amdgcn_rsqf(sq * (1.0f / 2048.0f) + 1e-6f);
                bf16_t* rowp = U + (size_t)row * ldc + col0;
#pragma unroll
                for (int bj = 0; bj < 2; ++bj) {
                    f32x4 v0 = acc[ai][bj][m][0] * rs, v1 = acc[ai][bj][m][1] * rs;
#pragma unroll
                    for (int j = 0; j < 4; ++j) { const float a = fmaxf(v0[j], 0.f), b = fmaxf(v1[j], 0.f); v0[j] = a * a; v1[j] = b * b; }
                    u32x4 w; w.x = pk2(v0[0], v0[1]); w.y = pk2(v0[2], v0[3]); w.z = pk2(v1[0], v1[1]); w.w = pk2(v1[2], v1[3]);
                    if (!(PM & 2)) *(u32x4*)(rowp + bj * HALF) = w; else asm volatile("" :: "v"(w));
                }
            }
    }
};
typedef EpiUpT<0> EpiUp;
template <class Epi, class Sched, bool ALIGN_EPI = false, bool SP2 = false>
__device__ __forceinline__ void gemm_phase(PG8_LAS unsigned char* lds, const Gemm g, const Sched& S, const Epi& E) {
    int tid = threadIdx.x; asm volatile("" : "+v"(tid));
    const int wid = __builtin_amdgcn_readfirstlane(tid >> 6), lane = tid & 63, wr = wid >> 2, wc = wid & 3, fr = lane & 15, fq = lane >> 4;
    const int K = g.K;
    unsigned voffA[2], voffB[2];
#pragma unroll
    for (int i = 0; i < 2; ++i) { int R, C; stage_rc(tid * 16 + i * 8192, R, C); const int Rb = Epi::PERM ? ((R & ~31) + perm32(R & 31)) : R;
        voffA[i] = (unsigned)(R * K + C) * 2u; voffB[i] = (unsigned)(Rb * K + C) * 2u; }
    const size_t kstep = (size_t)(BK * 2);
    const size_t hstep = (size_t)HALF * K * 2;
    const size_t tstep = 2 * hstep;
    const unsigned ldsw = (unsigned)wid * 1024u;
    const int aoff = lds_byte(wr * 64 + fr, fq * 8), boff = lds_byte(wc * 32 + fr, fq * 8);
#define PG8_SA(b, h) (((b) * 2 + (h)) * HTB)
#define PG8_SB(b, h) ((4 + (b) * 2 + (h)) * HTB)
#define PG8_STAGE(bufoff, gbase, voff) do { _Pragma("unroll") for (int _i = 0; _i < 2; ++_i) \
        __builtin_amdgcn_global_load_lds((const unsigned*)((const char*)(gbase) + (voff)[_i]), (PG8_LAS unsigned*)(lds + (bufoff) + ldsw + _i * 8192), 16, 0, 0); } while (0)
#define PG8_LDA(dst, b, h) do { _Pragma("unroll") for (int m = 0; m < 4; ++m) _Pragma("unroll") for (int k = 0; k < 2; ++k) dst[m][k] = *(const PG8_LAS bf16x8*)(lds + PG8_SA(b, h) + aoff + m * 2048 + k * 1024); } while (0)
#define PG8_LDB(dst, b, h) do { _Pragma("unroll") for (int n = 0; n < 2; ++n) _Pragma("unroll") for (int k = 0; k < 2; ++k) dst[n][k] = *(const PG8_LAS bf16x8*)(lds + PG8_SB(b, h) + boff + n * 2048 + k * 1024); } while (0)
#define PG8_MMA(ai, bj, At, Bt) do { __builtin_amdgcn_s_setprio(1); _Pragma("unroll") for (int m = 0; m < 4; ++m) _Pragma("unroll") for (int n = 0; n < 2; ++n) _Pragma("unroll") for (int k = 0; k < 2; ++k) \
        acc[ai][bj][m][n] = __builtin_amdgcn_mfma_f32_16x16x32_bf16(Bt[n][k], At[m][k], acc[ai][bj][m][n], 0, 0, 0); __builtin_amdgcn_s_setprio(0); } while (0)
#define PG8_WAIT_V(n) asm volatile("s_waitcnt vmcnt(" #n ")" ::: "memory")
#define PG8_WAIT_L(n) asm volatile("s_waitcnt lgkmcnt(" #n ")" ::: "memory")
#define PG8_BAR __builtin_amdgcn_s_barrier()
#define PG8_SCHED __builtin_amdgcn_sched_barrier(0)
    Unit cur, nxt; int ui = 0;
    if (!S.next(0, cur)) return;
    f32x4 acc[2][2][4][2];
#pragma unroll
    for (int a = 0; a < 2; ++a)
#pragma unroll
        for (int b = 0; b < 2; ++b)
#pragma unroll
            for (int m = 0; m < 4; ++m)
#pragma unroll
                for (int n = 0; n < 2; ++n) acc[a][b][m][n] = (f32x4){0.f, 0.f, 0.f, 0.f};
    bf16x8 At[4][2], B0[2][2], B1[2][2];
    const char* cA = (const char*)g.A + (size_t)cur.pm * tstep + cur.koff; const char* cB = (const char*)g.Bt + (size_t)cur.pn * tstep + cur.koff;
    S.a_ready(cur);
    if constexpr (SP2) {
        PG8_STAGE(PG8_SB(0, 0), cB, voffB); PG8_STAGE(PG8_SB(0, 1), cB + hstep, voffB); PG8_STAGE(PG8_SA(0, 0), cA, voffA); PG8_STAGE(PG8_SA(0, 1), cA + hstep, voffA);
        if (wr == 1) PG8_BAR;
        PG8_WAIT_V(2); PG8_BAR;
        PG8_STAGE(PG8_SB(1, 0), cB + kstep, voffB); PG8_STAGE(PG8_SA(1, 0), cA + kstep, voffA); PG8_STAGE(PG8_SB(1, 1), cB + hstep + kstep, voffB);
        PG8_WAIT_V(6); PG8_BAR;
    } else {
        PG8_STAGE(PG8_SB(0, 0), cB, voffB); PG8_STAGE(PG8_SA(0, 0), cA, voffA); PG8_STAGE(PG8_SB(0, 1), cB + hstep, voffB); PG8_STAGE(PG8_SA(0, 1), cA + hstep, voffA);
        if (wr == 1) PG8_BAR;
        PG8_WAIT_V(4); PG8_BAR;
        PG8_STAGE(PG8_SB(1, 0), cB + kstep, voffB); PG8_STAGE(PG8_SA(1, 0), cA + kstep, voffA); PG8_STAGE(PG8_SB(1, 1), cB + hstep + kstep, voffB);
        PG8_WAIT_V(6); PG8_BAR;
    }
    for (;;) {
        const bool has_next = S.next(ui + 1, nxt);
        const char* nA = has_next ? (const char*)g.A + (size_t)nxt.pm * tstep + nxt.koff : cA; const char* nB = has_next ? (const char*)g.Bt + (size_t)nxt.pn * tstep + nxt.koff : cB;
        const int nt = cur.nt;
        for (int t = 0; t < nt; t += 2) {
            const bool last = (t == nt - 2);
            const char* a1 = cA + (size_t)(t + 1) * kstep;
            const char* a2 = last ? nA : cA + (size_t)(t + 2) * kstep; const char* b2 = last ? nB : cB + (size_t)(t + 2) * kstep;
            const char* a3 = a2 + kstep; const char* b3 = b2 + kstep;
            if (last && has_next) S.a_ready(nxt);
            if constexpr (SP2) {
            PG8_LDB(B0, 0, 0); PG8_LDB(B1, 0, 1); PG8_SCHED; PG8_LDA(At, 0, 0); PG8_STAGE(PG8_SA(1, 1), a1 + hstep, voffA);
            PG8_WAIT_V(8); PG8_WAIT_L(0); PG8_BAR; PG8_MMA(0, 0, At, B0); PG8_MMA(0, 1, At, B1); PG8_BAR; PG8_SCHED;
            PG8_LDA(At, 0, 1); PG8_STAGE(PG8_SB(0, 0), b2, voffB); PG8_STAGE(PG8_SB(0, 1), b2 + hstep, voffB); PG8_STAGE(PG8_SA(0, 0), a2, voffA);
            PG8_WAIT_V(8); PG8_WAIT_L(0); PG8_BAR; PG8_MMA(1, 0, At, B0); PG8_MMA(1, 1, At, B1); PG8_BAR; PG8_SCHED;
            PG8_LDB(B0, 1, 0); PG8_LDB(B1, 1, 1); PG8_SCHED; PG8_LDA(At, 1, 0); PG8_STAGE(PG8_SA(0, 1), a2 + hstep, voffA);
            PG8_WAIT_V(8); PG8_WAIT_L(0); PG8_BAR; PG8_MMA(0, 0, At, B0); PG8_MMA(0, 1, At, B1); PG8_BAR; PG8_SCHED;
            PG8_LDA(At, 1, 1); PG8_STAGE(PG8_SB(1, 0), b3, voffB); PG8_STAGE(PG8_SB(1, 1), b3 + hstep, voffB); PG8_STAGE(PG8_SA(1, 0), a3, voffA);
            PG8_WAIT_V(8); PG8_WAIT_L(0); PG8_BAR; PG8_MMA(1, 0, At, B0); PG8_MMA(1, 1, At, B1); PG8_BAR; PG8_SCHED;
            } else {
            PG8_LDB(B0, 0, 0); PG8_SCHED; PG8_LDA(At, 0, 0); PG8_STAGE(PG8_SA(1, 1), a1 + hstep, voffA);
            PG8_WAIT_L(8); PG8_BAR; PG8_WAIT_L(0); PG8_MMA(0, 0, At, B0); PG8_BAR; PG8_SCHED;
            PG8_LDB(B1, 0, 1); PG8_STAGE(PG8_SB(0, 0), b2, voffB);
            PG8_BAR; PG8_WAIT_L(0); PG8_MMA(0, 1, At, B1); PG8_BAR;
            PG8_LDA(At, 0, 1); PG8_STAGE(PG8_SA(0, 0), a2, voffA);
            PG8_BAR; PG8_WAIT_L(0); PG8_MMA(1, 0, At, B0); PG8_BAR; PG8_SCHED;
            PG8_STAGE(PG8_SB(0, 1), b2 + hstep, voffB);
            PG8_WAIT_V(6); PG8_BAR; PG8_MMA(1, 1, At, B1); PG8_BAR;
            PG8_LDB(B0, 1, 0); PG8_SCHED; PG8_LDA(At, 1, 0); PG8_STAGE(PG8_SA(0, 1), a2 + hstep, voffA);
            PG8_WAIT_L(8); PG8_BAR; PG8_WAIT_L(0); PG8_MMA(0, 0, At, B0); PG8_BAR; PG8_SCHED;
            PG8_LDB(B1, 1, 1); PG8_STAGE(PG8_SB(1, 0), b3, voffB);
            PG8_BAR; PG8_WAIT_L(0); PG8_MMA(0, 1, At, B1); PG8_BAR;
            PG8_LDA(At, 1, 1); PG8_STAGE(PG8_SA(1, 0), a3, voffA);
            PG8_BAR; PG8_WAIT_L(0); PG8_MMA(1, 0, At, B0); PG8_BAR; PG8_SCHED;
            PG8_STAGE(PG8_SB(1, 1), b3 + hstep, voffB);
            PG8_WAIT_V(6); PG8_BAR; PG8_MMA(1, 1, At, B1); PG8_BAR;
            }
        }
        if constexpr (ALIGN_EPI) { if (wr == 0) PG8_BAR; }
        if constexpr (!Epi::AFTER_DRAIN) { E(acc, cur, wr, wc, fr, fq); S.done(cur); }
        if (!has_next) break;
#pragma unroll
        for (int a = 0; a < 2; ++a)
#pragma unroll
            for (int b = 0; b < 2; ++b)
#pragma unroll
                for (int m = 0; m < 4; ++m)
#pragma unroll
                    for (int n = 0; n < 2; ++n) acc[a][b][m][n] = (f32x4){0.f, 0.f, 0.f, 0.f};
        cur = nxt; cA = nA; cB = nB; ++ui;
        if constexpr (ALIGN_EPI) { if (wr == 1) PG8_BAR; }
    }
    PG8_WAIT_V(0);
    if constexpr (!ALIGN_EPI) { if (wr == 0) PG8_BAR; }
    PG8_BAR;
    if constexpr (Epi::AFTER_DRAIN) { E.fused(acc, cur, wr, wc, fr, fq, lds, wid, lane); S.done(cur); }
#undef PG8_SA
#undef PG8_SB
#undef PG8_STAGE
#undef PG8_LDA
#undef PG8_LDB
#undef PG8_MMA
#undef PG8_WAIT_V
#undef PG8_WAIT_L
#undef PG8_BAR
#undef PG8_SCHED
}
}
#define LAS __attribute__((address_space(3)))
#define DI __device__ __forceinline__
typedef unsigned short bf16;
typedef short bf16x8 __attribute__((ext_vector_type(8)));
typedef short s16x4 __attribute__((ext_vector_type(4)));
typedef float f32x4 __attribute__((ext_vector_type(4)));
typedef float f32x16 __attribute__((ext_vector_type(16)));
typedef unsigned u32x4 __attribute__((ext_vector_type(4)));
typedef unsigned u32x2 __attribute__((ext_vector_type(2)));
using pg8::pk2;
constexpr int DM = 2048, TP = 8192, NB = 32, TS = 64, MR = 10240, NL = 4, PAST = 2048, DIN = 6144, DFF = 8192, GW = 512;
constexpr float EPS = 1e-6f;
constexpr size_t MiB = 1u << 20;
constexpr size_t WS_CTL = 0, CTL_ZERO_BYTES = 1 * MiB;
constexpr size_t WS_WIN = 2 * MiB, WS_WOUT = WS_WIN + 96 * MiB, WS_WUP = WS_WOUT + 32 * MiB, WS_WDN = WS_WUP + 128 * MiB;
constexpr size_t WS_POOLW = WS_WDN + 128 * MiB;
constexpr size_t WS_XB = WS_POOLW + 1 * MiB;
constexpr size_t WS_Z = WS_XB + 40 * MiB;
constexpr size_t WS_GF = WS_Z + 120 * MiB;
constexpr size_t WS_MIX = WS_GF + 20 * MiB;
constexpr size_t WS_U = WS_MIX + 40 * MiB;
constexpr size_t WS_DS = WS_U + 160 * MiB;
constexpr size_t WS_HDEC = WS_DS + 64 * MiB;
constexpr size_t WS_SSQ = WS_HDEC + 1 * MiB;
constexpr size_t WS_SLAB = WS_SSQ + 12 * MiB;
constexpr size_t WS_LB = WS_SLAB + 64 * MiB;
constexpr size_t WS_END = WS_LB + 1 * MiB;
constexpr int CW_BAR = 4096, CW_Q = 8192, CW_DEP = 16384;
constexpr size_t O_Y = 0, O_RETP = 20971520, O_RETS = O_RETP + 262144, O_SBKP = O_RETS + 8388608, O_SBVP = O_SBKP + 16777216, O_SBKS = O_SBVP + 16777216,
                 O_SBVS = O_SBKS + 4194304, O_POOLP = O_SBVS + 4194304, O_POOLS = O_POOLP + 30720, O_HGP = O_POOLS + 983040, O_HGS = O_HGP + 262144, O_END = O_HGS + 8388608;
constexpr int LDS_CTL_OFF = 131072, LDS_BYTES = 147456;

DI float bflo(unsigned w) { return __uint_as_float(w << 16); }
DI float bfhi(unsigned w) { return __uint_as_float(w & 0xffff0000u); }
DI float fexp2(float x) { return __builtin_amdgcn_exp2f(x); }
DI float flog2(float x) { return __builtin_amdgcn_logf(x); }
DI float fexp(float x) { return __builtin_amdgcn_exp2f(x * 1.4426950408889634f); }
DI float sigmoidf_(float x) { return __builtin_amdgcn_rcpf(1.0f + fexp(-x)); }
#define MFMA32(a, b, c) __builtin_amdgcn_mfma_f32_32x32x16_bf16((a), (b), (c), 0, 0, 0)
DI int crow(int reg, int h) { return (reg & 3) + 8 * (reg >> 2) + 4 * h; }
constexpr unsigned RS = 272, TRS = 320;
DI bf16x8 ld_row(LAS const unsigned char* base, unsigned row, unsigned s, unsigned h) { return *(LAS const bf16x8*)(base + RS * row + 32u * s + 16u * h); }
DI s16x4 tr4(LAS const unsigned char* base, unsigned row0, unsigned c, unsigned lane) {
    const unsigned blk = (lane >> 4) & 1u, q = (lane & 15u) >> 2, p = lane & 3u;
    return __builtin_amdgcn_ds_read_tr16_b64_v4i16((LAS s16x4*)(base + TRS * (row0 + q) + 64u * c + 32u * blk + 8u * p));
}
DI bf16x8 tr8(LAS const unsigned char* base, unsigned rowA, unsigned rowB, unsigned c, unsigned lane) {
    const s16x4 lo = tr4(base, rowA, c, lane), hi = tr4(base, rowB, c, lane);
    return __builtin_shufflevector(lo, hi, 0, 1, 2, 3, 4, 5, 6, 7);
}
DI bf16x8 pack8(float a0, float a1, float a2, float a3, float a4, float a5, float a6, float a7) {
    u32x4 p; p.x = pk2(a0, a1); p.y = pk2(a2, a3); p.z = pk2(a4, a5); p.w = pk2(a6, a7); return __builtin_bit_cast(bf16x8, p);
}
DI f32x16 zero16() { f32x16 z; for (int i = 0; i < 16; ++i) z[i] = 0.f; return z; }
DI int wq_claim(unsigned* ctr) { return (threadIdx.x == 0) ? (int)__hip_atomic_fetch_add(ctr, 1u, __ATOMIC_RELAXED, __HIP_MEMORY_SCOPE_AGENT) : 0; }
DI int wq_next(unsigned* ctr, volatile LAS int* slot, int& pre, int& par) {
    if (threadIdx.x == 0) slot[par] = pre;
    __syncthreads();
    const int it = slot[par];
    par ^= 1;
    pre = wq_claim(ctr);
    return it;
}
DI void st_wt(float* p, float v) { __hip_atomic_store((unsigned*)p, __float_as_uint(v), __ATOMIC_RELAXED, __HIP_MEMORY_SCOPE_AGENT); }
DI float ld_wt(const float* p) { return __uint_as_float(__hip_atomic_load((const unsigned*)p, __ATOMIC_RELAXED, __HIP_MEMORY_SCOPE_AGENT)); }
DI void st_wt32(unsigned* p, unsigned v) { __hip_atomic_store(p, v, __ATOMIC_RELAXED, __HIP_MEMORY_SCOPE_AGENT); }
DI unsigned ld_wt32(const unsigned* p) { return __hip_atomic_load(p, __ATOMIC_RELAXED, __HIP_MEMORY_SCOPE_AGENT); }
DI unsigned long long ld_wt64(const unsigned long long* p) { return __hip_atomic_load(p, __ATOMIC_RELAXED, __HIP_MEMORY_SCOPE_AGENT); }
DI void dep_publish(unsigned* ctr) {
    asm volatile("s_waitcnt vmcnt(0)" ::: "memory");
    __syncthreads();
    if (threadIdx.x == 0) __hip_atomic_fetch_add(ctr, 1u, __ATOMIC_RELAXED, __HIP_MEMORY_SCOPE_AGENT);
}
DI void dep_wait(unsigned* ctr, const unsigned need, unsigned* tmo) {
    if (threadIdx.x == 0) {
        unsigned sp = 0;
        while (__hip_atomic_load(ctr, __ATOMIC_RELAXED, __HIP_MEMORY_SCOPE_AGENT) < need) {
            __builtin_amdgcn_s_sleep(2);
            if ((++sp & 1023u) == 0u) { if (__hip_atomic_load(tmo, __ATOMIC_RELAXED, __HIP_MEMORY_SCOPE_AGENT) != 0u) break; if (sp > (1u << 22)) { __hip_atomic_fetch_add(tmo, 1u, __ATOMIC_RELAXED, __HIP_MEMORY_SCOPE_AGENT); break; } }
        }
        __builtin_amdgcn_fence(__ATOMIC_ACQUIRE, "agent");
        asm volatile("s_waitcnt vmcnt(0)" ::: "memory");
    }
    __syncthreads();
}
DI void dep_wait_sc1(unsigned* ctr, const unsigned need, unsigned* tmo) {
    if (threadIdx.x == 0) {
        unsigned sp = 0;
        while (__hip_atomic_load(ctr, __ATOMIC_RELAXED, __HIP_MEMORY_SCOPE_AGENT) < need) {
            __builtin_amdgcn_s_sleep(2);
            if ((++sp & 1023u) == 0u) { if (__hip_atomic_load(tmo, __ATOMIC_RELAXED, __HIP_MEMORY_SCOPE_AGENT) != 0u) break; if (sp > (1u << 22)) { __hip_atomic_fetch_add(tmo, 1u, __ATOMIC_RELAXED, __HIP_MEMORY_SCOPE_AGENT); break; } }
        }
    }
    __builtin_amdgcn_fence(__ATOMIC_ACQUIRE, "wavefront");
    __syncthreads();
}
#define XB_TMO      128
#define XB_XCNT(j)  (256  + 64 * (j))
#define XB_XSUB(j)  (1280 + 64 * (j))
#define XB_XGEN(j)  (2304 + 64 * (j))
#define XB_TOP      3328
#define XB_TOPGEN   3392
#define XCD_BAR_WORDS 3456
#define XB_SPIN_CAP (1u << 18)

__device__ __forceinline__ unsigned xb_ld(unsigned* p)              { return __hip_atomic_load(p, __ATOMIC_RELAXED, __HIP_MEMORY_SCOPE_AGENT); }
__device__ __forceinline__ unsigned xb_add(unsigned* p, unsigned v) { return __hip_atomic_fetch_add(p, v, __ATOMIC_RELAXED, __HIP_MEMORY_SCOPE_AGENT); }
__device__ __forceinline__ unsigned xb_xcc_id() { return (unsigned)__builtin_amdgcn_s_getreg((3 << 11) | 20) & 0xFu; }
#define XB_SPIN(cond, bar) do { unsigned _sp = 0; while (cond) { __builtin_amdgcn_s_sleep(1); \
    if ((++_sp & 255u) == 0u) { if (xb_ld(&(bar)[XB_TMO])) break; if (_sp > XB_SPIN_CAP) { atomicAdd(&(bar)[XB_TMO], 1u); break; } } } } while (0)

struct XcdBarrier {
    unsigned* bar; unsigned x;
    volatile LAS unsigned* st;
};

__device__ __forceinline__ XcdBarrier xcd_barrier_post(unsigned* bar, volatile LAS unsigned* st) {
    XcdBarrier b; b.bar = bar; b.x = xb_xcc_id(); b.st = st;
    if (threadIdx.x == 0) (void)xb_add(&bar[XB_XCNT(b.x)], 1u);
    return b;
}
__device__ __forceinline__ void xcd_barrier_complete(unsigned* bar, unsigned x, unsigned& nloc, unsigned& nx) {
    const unsigned G = gridDim.x * gridDim.y * gridDim.z;
    unsigned sum, cnt, mine, sp = 0u;
    for (;;) {
        sum = 0u; cnt = 0u; mine = 0u;
#pragma unroll
        for (unsigned j = 0; j < 16; ++j) { const unsigned c = xb_ld(&bar[XB_XCNT(j)]); sum += c; cnt += (c > 0u) ? 1u : 0u; mine = (j == x) ? c : mine; }
        if (sum == G) break;
        __builtin_amdgcn_s_sleep(1);
        if ((++sp & 255u) == 0u) { if (xb_ld(&bar[XB_TMO])) break; if (sp > XB_SPIN_CAP) { atomicAdd(&bar[XB_TMO], 1u); break; } }
    }
    nloc = mine > 0u ? mine : 1u; nx = cnt > 0u ? cnt : 1u;
}

__device__ __forceinline__ void xcd_barrier(const XcdBarrier& b) {
    asm volatile("s_waitcnt vmcnt(0)" ::: "memory");
    __syncthreads();
    if (threadIdx.x == 0) {
        unsigned* bar = b.bar;
        __builtin_amdgcn_s_waitcnt(0);
        unsigned nloc = b.st[0], nx = b.st[1];
        if (nloc == 0u) { xcd_barrier_complete(bar, b.x, nloc, nx); b.st[0] = nloc; b.st[1] = nx; }
        const unsigned old = xb_add(&bar[XB_XSUB(b.x)], 1u);
        const unsigned gen = old / nloc;
        if (old + 1u == (gen + 1u) * nloc) {
            __builtin_amdgcn_fence(__ATOMIC_RELEASE, "agent");
            asm volatile("s_waitcnt vmcnt(0)" ::: "memory");
            const unsigned og = xb_add(&bar[XB_TOP], 1u);
            const unsigned tg = og / nx;
            if (og + 1u == (tg + 1u) * nx) xb_add(&bar[XB_TOPGEN], 1u);
            else XB_SPIN(xb_ld(&bar[XB_TOPGEN]) == tg, bar);
            __builtin_amdgcn_fence(__ATOMIC_ACQUIRE, "agent");
            xb_add(&bar[XB_XGEN(b.x)], 1u);
            asm volatile("s_waitcnt vmcnt(0)" ::: "memory");
        } else {
            XB_SPIN(xb_ld(&bar[XB_XGEN(b.x)]) == gen, bar);
            __builtin_amdgcn_fence(__ATOMIC_ACQUIRE, "agent");
            asm volatile("s_waitcnt vmcnt(0)" ::: "memory");
        }
    }
    __syncthreads();
}
struct TrItem { const float* src; bf16* dst; int N, K; f32x4 gq[4]; float cs; };
DI void tr_setup(TrItem& t, const float* W, const int K, const int N, bf16* WT, const float* kgain, const int cs_lo1, const int cs_hi1, const float cs1, const int cs_lo2, const int cs_hi2, const float cs2,
                 const int item, const int lane) {
    const int nblk = N / 64, kb = item / nblk, nb = item % nblk, k0 = 64 * kb, n0 = 64 * nb;
    const int n4 = lane & 15, kq = lane >> 4, ncol = n0 + 4 * n4;
    const float cs = (ncol >= cs_lo1 && ncol < cs_hi1) ? cs1 : ((ncol >= cs_lo2 && ncol < cs_hi2) ? cs2 : 1.0f);
    t.src = W + (size_t)(k0 + 8 * kq) * N + ncol; t.dst = WT + (size_t)ncol * K + k0 + 8 * kq; t.N = N; t.K = K;
    t.cs = cs;
#pragma unroll
    for (int q = 0; q < 4; ++q) t.gq[q] = *(const f32x4*)(kgain + k0 + 8 * kq + 4 * (q & 1) + 32 * (q >> 1));
}
DI void tr_load(const TrItem& t, f32x4 (&v)[16]) {
#pragma unroll
    for (int i = 0; i < 16; ++i) v[i] = __builtin_nontemporal_load((const f32x4*)(t.src + (size_t)((i & 7) + 32 * (i >> 3)) * t.N));
}
DI void tr_store(const TrItem& t, const f32x4 (&v)[16]) {
    float gk[16];
#pragma unroll
    for (int i = 0; i < 16; ++i) gk[i] = t.gq[i >> 2][i & 3] * t.cs;
#pragma unroll
    for (int e = 0; e < 4; ++e) {
        bf16* dst = t.dst + (size_t)e * t.K;
        *(bf16x8*)(dst) = pack8(v[0][e] * gk[0], v[1][e] * gk[1], v[2][e] * gk[2], v[3][e] * gk[3], v[4][e] * gk[4], v[5][e] * gk[5], v[6][e] * gk[6], v[7][e] * gk[7]);
        *(bf16x8*)(dst + 32) = pack8(v[8][e] * gk[8], v[9][e] * gk[9], v[10][e] * gk[10], v[11][e] * gk[11], v[12][e] * gk[12], v[13][e] * gk[13], v[14][e] * gk[14], v[15][e] * gk[15]);
    }
}
constexpr int CV_IN = (DM / 64) * (DIN / 64), CV_OUT = (DM / 64) * (DM / 64), CV_UP = (DM / 64) * (DFF / 64), CV_DN = (DFF / 64) * (DM / 64);
DI void conv_setup(TrItem& t, const float* w_in, const float* w_out, const float* w_up, const float* w_down, const float* norm1_g, const float* norm2_g, const float* ones, bf16* WinT, bf16* WoutT, bf16* WupT, bf16* WdnT,
                   const int l, const int rr, const int lane) {
    const int which = (rr >= CV_IN) + (rr >= CV_IN + CV_OUT) + (rr >= CV_IN + CV_OUT + CV_UP);
    const int item = rr - (which >= 1 ? CV_IN : 0) - (which >= 2 ? CV_OUT : 0) - (which >= 3 ? CV_UP : 0);
    const float* W = which == 0 ? w_in + (size_t)l * DM * DIN : which == 1 ? w_out + (size_t)l * DM * DM : which == 2 ? w_up + (size_t)l * DM * DFF : w_down + (size_t)l * DFF * DM;
    bf16* WT = which == 0 ? WinT + (size_t)l * DIN * DM : which == 1 ? WoutT + (size_t)l * DM * DM : which == 2 ? WupT + (size_t)l * DFF * DM : WdnT + (size_t)l * DM * DFF;
    const int K = which == 3 ? DFF : DM, N = which == 0 ? DIN : which == 2 ? DFF : DM;
    const float* kg = which == 0 ? norm1_g + l * DM : which == 2 ? norm2_g + l * DM : ones;
    const int lo1 = which == 0 ? 512 : 0, hi1 = which == 0 ? 1024 : 0, lo2 = which == 0 ? 2048 : 0, hi2 = which == 0 ? 2560 : 0;
    tr_setup(t, W, K, N, WT, kg, lo1, hi1, 0.08838834764831845f, lo2, hi2, 0.08838834764831845f * 1.4426950408889634f, item, lane);
}
DI void conv_wave_pair(const float* w_in, const float* w_out, const float* w_up, const float* w_down, const float* norm1_g, const float* norm2_g, const float* ones, bf16* WinT, bf16* WoutT, bf16* WupT, bf16* WdnT,
                       const int l0, const int r0, const int l1, const int r1, const int lane) {
    TrItem t0, t1; f32x4 v0[16], v1[16];
    conv_setup(t0, w_in, w_out, w_up, w_down, norm1_g, norm2_g, ones, WinT, WoutT, WupT, WdnT, l0, r0, lane); tr_load(t0, v0);
    conv_setup(t1, w_in, w_out, w_up, w_down, norm1_g, norm2_g, ones, WinT, WoutT, WupT, WdnT, l1, r1, lane); tr_load(t1, v1);
    tr_store(t0, v0); tr_store(t1, v1);
}
struct ConvCtx { const float* w_in; const float* w_out; const float* w_up; const float* w_down; const float* norm1_g; const float* norm2_g; const float* ones; bf16* WinT; bf16* WoutT; bf16* WupT; bf16* WdnT; };
DI bool conv_list_setup(TrItem& t, const ConvCtx& c, const int l, const int wi_in, const int lane) {
    const bool on = (wi_in >= 0) && ((wi_in < CV_OUT + CV_UP + CV_DN) || (l + 1 < NL));
    const int wi = on ? wi_in : 0;
    const bool nextl = wi >= CV_OUT + CV_UP + CV_DN;
    conv_setup(t, c.w_in, c.w_out, c.w_up, c.w_down, c.norm1_g, c.norm2_g, c.ones, c.WinT, c.WoutT, c.WupT, c.WdnT, nextl ? l + 1 : l, nextl ? wi - (CV_OUT + CV_UP + CV_DN) : CV_IN + wi, lane);
    return on;
}
struct SbArgs {
    const bf16* zq; const bf16* zk; const bf16* zv;
    const float* kc; const float* vc;
    int nf32, t_hi, qpos0, nqw;
    bf16* mixo;
    float* ok; int ovd, own_lo;
};
typedef float f32x2 __attribute__((ext_vector_type(2)));
DI void sb_sub(LAS const unsigned char* Kb, LAS const unsigned char* Vb, const bf16x8 (&qf)[8], f32x16 (&O)[4], float& R, const int kt, const int kp_base, const int qp,
               const bool needmask, const int r, const int h, const int lane) {
    f32x16 X = zero16();
#pragma unroll
    for (int s = 0; s < 8; ++s) X = MFMA32(ld_row(Kb, 32 * kt + r, s, h), qf[s], X);
    f32x2 E[8], F[8];
#pragma unroll
    for (int p = 0; p < 2; ++p)
#pragma unroll
        for (int jj = 0; jj < 4; ++jj) {
            f32x2 u2 = {X[8 * p + jj], X[8 * p + 4 + jj]};
            u2 = __builtin_elementwise_min(u2, (f32x2){64.f, 64.f});
            f32x2 e2; e2.x = fexp2(u2.x); e2.y = fexp2(u2.y);
            const f32x2 d2 = e2 + 1.0f;
            f32x2 f2; f2.x = __builtin_amdgcn_rcpf(d2.x); f2.y = __builtin_amdgcn_rcpf(d2.y);
            E[4 * p + jj] = e2; F[4 * p + jj] = f2;
        }
    if (needmask) {
#pragma unroll
        for (int p = 0; p < 2; ++p)
#pragma unroll
            for (int jj = 0; jj < 4; ++jj) {
                const int kpa = kp_base + 4 * h + jj + 8 * (2 * p), kpb = kpa + 8;
                const bool va = kpa < qp, vb = kpb < qp;
                E[4 * p + jj].x = va ? E[4 * p + jj].x : 0.f; F[4 * p + jj].x = va ? F[4 * p + jj].x : 1.f;
                E[4 * p + jj].y = vb ? E[4 * p + jj].y : 0.f; F[4 * p + jj].y = vb ? F[4 * p + jj].y : 1.f;
            }
    }
    float gp[4], pp[4], pt[4], T[4];
#pragma unroll
    for (int p = 0; p < 2; ++p) { const f32x2 g2 = (F[4 * p] * F[4 * p + 1]) * (F[4 * p + 2] * F[4 * p + 3]); gp[2 * p] = g2.x; gp[2 * p + 1] = g2.y; }
#pragma unroll
    for (int g = 0; g < 4; ++g) { const unsigned x = __float_as_uint(gp[g]); const auto sw = __builtin_amdgcn_permlane32_swap(x, x, false, false);
        const float a0 = __uint_as_float(sw[0]), a1 = __uint_as_float(sw[1]);
        pp[g] = a0 * a1; pt[g] = (h == 0) ? a1 : 1.0f; }
    T[3] = 1.0f; T[2] = pp[3]; T[1] = T[2] * pp[2]; T[0] = T[1] * pp[1];
    float P[16];
#pragma unroll
    for (int p = 0; p < 2; ++p) {
        f32x2 c2 = {R * T[2 * p] * pt[2 * p], R * T[2 * p + 1] * pt[2 * p + 1]};
#pragma unroll
        for (int jj = 3; jj >= 0; --jj) { c2 = c2 * F[4 * p + jj]; const f32x2 a2 = E[4 * p + jj] * c2; P[8 * p + jj] = a2.x; P[8 * p + 4 + jj] = a2.y; }
    }
    R = R * (T[0] * pp[0]);
    const bf16x8 pa0 = pack8(P[0], P[1], P[2], P[3], P[4], P[5], P[6], P[7]), pa1 = pack8(P[8], P[9], P[10], P[11], P[12], P[13], P[14], P[15]);
#pragma unroll
    for (int ei = 0; ei < 4; ++ei) {
        const bf16x8 vb0 = tr8(Vb, 32 * kt + 4 * h, 32 * kt + 8 + 4 * h, ei, lane);
        O[ei] = MFMA32(pa0, vb0, O[ei]);
        const bf16x8 vb1 = tr8(Vb, 32 * kt + 16 + 4 * h, 32 * kt + 24 + 4 * h, ei, lane);
        O[ei] = MFMA32(pa1, vb1, O[ei]);
    }
}
constexpr int SB_V0 = 64 * 272, SB_BUF = 64 * 272 + 64 * 320;
constexpr int SB_CVN = 4;
DI void sb_item(LAS unsigned char* lds, const SbArgs& a, const ConvCtx& cvx, const int cv_l, const int cv_base, const int tid_in) {
    int tid = tid_in; asm volatile("" : "+v"(tid));
    const int lane = tid & 63, w = __builtin_amdgcn_readfirstlane(tid >> 6), r = lane & 31, h = lane >> 5;
    const bool active = w < a.nqw;
    u32x4 st[4];
#define SB_LOAD(j) do { if ((j) < a.nf32) { \
        _Pragma("unroll") for (int i_ = 0; i_ < 2; ++i_) { const int n_ = tid + 512 * i_, row_ = n_ >> 5, c4_ = n_ & 31; const size_t o_ = (size_t)(32 * (j) + row_) * 512 + 4 * c4_; \
            st[i_] = *(const u32x4*)(a.kc + o_); st[2 + i_] = *(const u32x4*)(a.vc + o_); } \
    } else { const int jj_ = (j) - a.nf32; \
        _Pragma("unroll") for (int i_ = 0; i_ < 2; ++i_) { const int n_ = tid + 512 * i_, row_ = n_ >> 4, ch_ = n_ & 15; const size_t o_ = (size_t)(64 * jj_ + row_) * 6144 + 8 * ch_; \
            st[i_] = *(const u32x4*)(a.zk + o_); st[2 + i_] = *(const u32x4*)(a.zv + o_); } } } while (0)
#define SB_WRITE(j, Kd, Vd) do { if ((j) < a.nf32) { \
        _Pragma("unroll") for (int i_ = 0; i_ < 2; ++i_) { const int n_ = tid + 512 * i_, row_ = n_ >> 5, c4_ = n_ & 31; const unsigned ok_ = RS * row_ + 8u * c4_, ov_ = TRS * row_ + 8u * c4_; \
            u32x2 kk_, vv_; kk_.x = pk2(__uint_as_float(st[i_].x), __uint_as_float(st[i_].y)); kk_.y = pk2(__uint_as_float(st[i_].z), __uint_as_float(st[i_].w)); \
            vv_.x = pk2(__uint_as_float(st[2 + i_].x), __uint_as_float(st[2 + i_].y)); vv_.y = pk2(__uint_as_float(st[2 + i_].z), __uint_as_float(st[2 + i_].w)); \
            *(LAS u32x2*)((Kd) + ok_) = kk_; *(LAS u32x2*)((Vd) + ov_) = vv_; } \
    } else { const bool own_ = (j) >= a.own_lo; const int jw_ = (j) - a.nf32; \
        _Pragma("unroll") for (int i_ = 0; i_ < 2; ++i_) { const int n_ = tid + 512 * i_, row_ = n_ >> 4, ch_ = n_ & 15; \
            *(LAS u32x4*)((Kd) + RS * row_ + 16u * ch_) = st[i_]; *(LAS u32x4*)((Vd) + TRS * row_ + 16u * ch_) = st[2 + i_]; \
            if (own_) { const unsigned oo_ = (unsigned)((64 * jw_ + row_) * 512 + 8 * ch_) * 4u; const u32x4 k_ = st[i_], v_ = st[2 + i_]; char* pk_ = (char*)a.ok; char* pv_ = (char*)(a.ok + a.ovd); \
                *(f32x4*)(pk_ + oo_) = (f32x4){bflo(k_.x), bfhi(k_.x), bflo(k_.y), bfhi(k_.y)}; *(f32x4*)(pk_ + oo_ + 16u) = (f32x4){bflo(k_.z), bfhi(k_.z), bflo(k_.w), bfhi(k_.w)}; \
                *(f32x4*)(pv_ + oo_) = (f32x4){bflo(v_.x), bfhi(v_.x), bflo(v_.y), bfhi(v_.y)}; *(f32x4*)(pv_ + oo_ + 16u) = (f32x4){bflo(v_.z), bfhi(v_.z), bflo(v_.w), bfhi(v_.w)}; } } } } while (0)
#define SB_WALK(BODY, FLAG) do { int cur = 0; \
    for (int j = a.t_hi; j >= 0; --j) { \
        LAS unsigned char* Kb = lds + cur * SB_BUF; LAS unsigned char* Vb = Kb + SB_V0; \
        if (j > 0) SB_LOAD(j - 1); \
        BODY \
        if (j > 0) SB_WRITE(j - 1, lds + (cur ^ 1) * SB_BUF, lds + (cur ^ 1) * SB_BUF + SB_V0); \
        if (lane == 0) dflag[8 * cur + w] = (FLAG) ? 1 : 0; \
        __syncthreads(); \
        {   int alld = 1; \
            _Pragma("unroll") for (int i = 0; i < 8; ++i) alld &= dflag[8 * cur + i]; \
            if (alld) break; } \
        cur ^= 1; \
    } } while (0)
    volatile LAS int* dflag = (volatile LAS int*)(lds + 2 * SB_BUF);
    if (active) {
        bf16x8 qf[8];
        {   const bf16* qp_ = a.zq + (size_t)(32 * w + r) * 6144 + 8 * h;
#pragma unroll
            for (int s = 0; s < 8; ++s) qf[s] = *(const bf16x8*)(qp_ + 16 * s); }
        f32x16 O[4]; O[0] = zero16(); O[1] = zero16(); O[2] = zero16(); O[3] = zero16();
        float R = 1.0f;
        const int qmin = a.qpos0 + 32 * w, qmax = qmin + 31, qp = qmin + r;
        SB_LOAD(a.t_hi); SB_WRITE(a.t_hi, lds, lds + SB_V0);
        __syncthreads();
        SB_WALK({
            const bool f32t = j < a.nf32;
            const int kp0 = f32t ? 32 * j : 32 * a.nf32 + 64 * (j - a.nf32);
            const int nk = f32t ? 32 : 64;
            if (kp0 < qmax) {
                const bool needmask = (kp0 + nk - 1 >= qmin);
                if (!f32t) sb_sub(Kb, Vb, qf, O, R, 1, kp0 + 32, qp, needmask, r, h, lane);
                sb_sub(Kb, Vb, qf, O, R, 0, kp0, qp, needmask, r, h, lane);
            } }, (__ballot(R != 0.0f) == 0ull));
        LAS unsigned char* ob = lds + w * 8192;
#pragma unroll
        for (int ei = 0; ei < 4; ++ei)
#pragma unroll
            for (int i = 0; i < 16; ++i) *(LAS unsigned short*)(ob + crow(i, h) * 256 + (32 * ei + r) * 2) = (unsigned short)(pk2(O[ei][i], 0.f) & 0xffffu);
#pragma unroll
        for (int i = 0; i < 8; ++i) { const int n = lane + 64 * i, row = n >> 4, ch = n & 15;
            const u32x4 v = *(LAS const u32x4*)(ob + row * 256 + ch * 16);
            *(u32x4*)(a.mixo + (size_t)(32 * w + row) * 2048 + 8 * ch) = v; }
    } else {
        TrItem tA; f32x4 vA[16]; bool onA = false;
        const int cvw = cv_base + (w - a.nqw) * SB_CVN;
        int ci = (cv_base >= 0) ? 0 : SB_CVN, cs = ci;
        for (int i = 0; i < 16; ++i) vA[i] = (f32x4){0.f, 0.f, 0.f, 0.f};
        tA.src = nullptr; tA.dst = nullptr; tA.N = 0; tA.K = 0; tA.cs = 0.f;
        for (int q = 0; q < 4; ++q) tA.gq[q] = (f32x4){0.f, 0.f, 0.f, 0.f};
        SB_LOAD(a.t_hi); SB_WRITE(a.t_hi, lds, lds + SB_V0);
        __syncthreads();
        SB_WALK({
            if (cs < ci) { if (onA) tr_store(tA, vA); ++cs; }
            if (ci < SB_CVN) { onA = conv_list_setup(tA, cvx, cv_l, cvw + ci, lane); tr_load(tA, vA); ++ci; } }, true);
        while (cs < SB_CVN) {
            if (cs == ci) { onA = conv_list_setup(tA, cvx, cv_l, cvw + ci, lane); tr_load(tA, vA); ++ci; }
            if (onA) tr_store(tA, vA);
            ++cs; }
    }
#undef SB_WALK
#undef SB_LOAD
#undef SB_WRITE
}
constexpr int LA_QT = 0, LA_QI = 17408, LA_KT = 34816, LA_KS = 52224, LA_VV = 72704, LA_G = 93184;
struct LaArgs {
    const bf16* z;
    int h, pos0, mode, prompt;
    const float* Sprev;
    const bf16* SpT;
    bf16* dSout;
    float* Sout;
    float* hdec;
    const float* ng;
    const float* lbsrc;
    int layer;
    bf16* mixo;
    unsigned* pub_prev;
    unsigned* dep_done; unsigned* dep_need; unsigned* tmo;
    int cv_wi;
};
template <int MIXER, int MODE>
DI void la_item(LAS unsigned char* lds, const LaArgs& a, const ConvCtx& cvx, const int tid_in) {
    int tid = tid_in; asm volatile("" : "+v"(tid));
    const int lane = tid & 63, w = __builtin_amdgcn_readfirstlane(tid >> 6), r = lane & 31, h = lane >> 5;
    LAS unsigned char* QT = lds + LA_QT; LAS unsigned char* QI = lds + LA_QI; LAS unsigned char* KT = lds + LA_KT; LAS unsigned char* KS = lds + LA_KS; LAS unsigned char* VV = lds + LA_VV;
    LAS float* G = (LAS float*)(lds + LA_G);
    bool pubdone = false;
    if (MODE == 2 && a.dep_need) { if (a.pub_prev) { dep_publish(a.pub_prev); pubdone = true; } dep_wait_sc1(a.dep_need, 16u, a.tmo); }
    float sv[8][8]; unsigned long long svq[8][2]; u32x4 gw0 = {0u, 0u, 0u, 0u}, gw1 = {0u, 0u, 0u, 0u}; f32x4 ngv[4];
    if (MODE == 2) {
        const unsigned long long* sp0 = (const unsigned long long*)(a.SpT + (32 * (w & 3) + r) * 128 + 8 * h);
#pragma unroll
        for (int s = 0; s < 8; ++s) { svq[s][0] = ld_wt64(sp0 + 4 * s); svq[s][1] = ld_wt64(sp0 + 4 * s + 1); }
    }
    if (MODE & 2) {
        const bf16* gz = a.z + (size_t)(tid >> 3) * 6144 + (MIXER == 0 ? 3 * 512 : 11 * 512) + a.h * 128 + 16 * (tid & 7);
        gw0 = *(const u32x4*)(gz); gw1 = *(const u32x4*)(gz + 8);
#pragma unroll
        for (int q4 = 0; q4 < 4; ++q4) ngv[q4] = *(const f32x4*)(a.ng + 16 * (tid & 7) + 4 * q4);
    }
    float decay_s = 1.f;
    if (MIXER == 0) {
        const float lg = flog2(1.0f - fexp2(-5.0f - (float)a.h));
        decay_s = fexp2(64.0f * lg);
        const int m = tid >> 3, j0 = 8 * (tid & 7);
        const bf16* zr = a.z + (size_t)m * 6144 + a.h * 128;
        const u32x4 q1 = *(const u32x4*)(zr + j0), q2 = *(const u32x4*)(zr + 64 + j0), k1 = *(const u32x4*)(zr + 512 + j0), k2 = *(const u32x4*)(zr + 512 + 64 + j0);
        const u32x4 v0 = *(const u32x4*)(zr + 1024 + 2 * j0), v1 = *(const u32x4*)(zr + 1024 + 2 * j0 + 8);
        const float posf = (float)(a.pos0 + m);
        const float sqt = fexp2((float)(m - 32) * lg), sqi = fexp2((float)(m + 1) * lg), skt = fexp2((float)(32 - m) * lg), sks = fexp2((float)(63 - m) * lg);
        float qa[8], qb[8], ka[8], kb[8];
#pragma unroll
        for (int jj = 0; jj < 8; ++jj) {
            const unsigned wq1 = q1[jj >> 1], wq2 = q2[jj >> 1], wk1 = k1[jj >> 1], wk2 = k2[jj >> 1];
            const float x1 = (jj & 1) ? bfhi(wq1) : bflo(wq1), x2 = (jj & 1) ? bfhi(wq2) : bflo(wq2), y1 = (jj & 1) ? bfhi(wk1) : bflo(wk1), y2 = (jj & 1) ? bfhi(wk2) : bflo(wk2);
            const float inv = fexp2(-(float)(j0 + jj) * (13.287712379549449f / 64.0f));
            const float ang = posf * inv;
            const float fr = __builtin_amdgcn_fractf(ang * 0.15915494309189535f);
            const float sn = __builtin_amdgcn_sinf(fr), cs = __builtin_amdgcn_cosf(fr);
            qa[jj] = x1 * cs - x2 * sn; qb[jj] = x1 * sn + x2 * cs; ka[jj] = y1 * cs - y2 * sn; kb[jj] = y1 * sn + y2 * cs;
        }
        const unsigned c1 = (unsigned)(tid & 7), c2 = c1 + 8u;
#define LA_ST(T, ST, ch, AR, sc) do { u32x4 p_; p_[0] = pk2(AR[0] * (sc), AR[1] * (sc)); p_[1] = pk2(AR[2] * (sc), AR[3] * (sc)); p_[2] = pk2(AR[4] * (sc), AR[5] * (sc)); p_[3] = pk2(AR[6] * (sc), AR[7] * (sc)); \
            *(LAS u32x4*)((T) + (ST) * m + 16u * (ch)) = p_; } while (0)
        if (MODE & 2) { LA_ST(QT, RS, c1, qa, sqt); LA_ST(QT, RS, c2, qb, sqt); LA_ST(QI, RS, c1, qa, sqi); LA_ST(QI, RS, c2, qb, sqi); LA_ST(KT, RS, c1, ka, skt); LA_ST(KT, RS, c2, kb, skt); }
        if (MODE & 1) { LA_ST(KS, TRS, c1, ka, sks); LA_ST(KS, TRS, c2, kb, sks); }
        *(LAS u32x4*)(VV + TRS * m + 32u * c1) = v0; *(LAS u32x4*)(VV + TRS * m + 32u * c1 + 16u) = v1;
    } else {
        const int m = tid >> 3, d0 = 16 * (tid & 7);
        const bf16* zr = a.z + (size_t)m * 6144 + a.h * 128 + d0;
        const u32x4 fw0 = *(const u32x4*)(zr + 9 * 512), fw1 = *(const u32x4*)(zr + 9 * 512 + 8);
        float kk[16];
#pragma unroll
        for (int q4 = 0; q4 < 4; ++q4) {
            f32x4 lfv;
#pragma unroll
            for (int jj = 0; jj < 4; ++jj) {
                const int c = a.h * 128 + d0 + 4 * q4 + jj;
                const float lb = a.lbsrc[c];
                const unsigned wf = (q4 < 2) ? fw0[(4 * q4 + jj) >> 1] : fw1[(4 * q4 + jj - 8) >> 1];
                const float x = (jj & 1) ? bfhi(wf) : bflo(wf);
                const float ex = fexp(-fmaxf(x, -80.0f)), sg = __builtin_amdgcn_rcpf(1.0f + ex);
                const float f = lb + (1.0f - lb) * sg;
                lfv[jj] = flog2(f) * 0.6931471805599453f;
                kk[4 * q4 + jj] = (1.0f - lb) * (ex * sg);
            }
            *(LAS f32x4*)(G + m * 128 + d0 + 4 * q4) = lfv;
        }
        __syncthreads();
        {
            const int d = tid & 127, seg = tid >> 7; float v[16]; float run = 0.f;
#pragma unroll
            for (int i = 0; i < 16; ++i) { run += G[(16 * seg + i) * 128 + d]; v[i] = run; }
#pragma unroll
            for (int i = 0; i < 16; ++i) G[(16 * seg + i) * 128 + d] = v[i];
            __syncthreads();
            float pre = 0.f;
#pragma unroll
            for (int s2 = 0; s2 < 3; ++s2) { const float t = G[(16 * s2 + 15) * 128 + d]; pre += (s2 < seg) ? t : 0.f; }
            __syncthreads();
            if (seg > 0) {
#pragma unroll
                for (int i = 0; i < 16; ++i) G[(16 * seg + i) * 128 + d] = v[i] + pre;
            }
        }
        __syncthreads();
        const u32x4 qw0 = *(const u32x4*)(zr + 8 * 512), qw1 = *(const u32x4*)(zr + 8 * 512 + 8);
        const u32x4 vw0 = *(const u32x4*)(zr + 10 * 512), vw1 = *(const u32x4*)(zr + 10 * 512 + 8);
        float qt[16], qi[16], kt[16], ks[16];
#pragma unroll
        for (int jj = 0; jj < 16; ++jj) {
            const unsigned wq = (jj < 8) ? qw0[jj >> 1] : qw1[(jj - 8) >> 1];
            const float qraw = (jj & 1) ? bfhi(wq) : bflo(wq);
            const float qs = qraw * sigmoidf_(qraw);
            const float g = G[m * 128 + d0 + jj], gm = G[31 * 128 + d0 + jj], gl = G[63 * 128 + d0 + jj];
            if (MODE & 2) { qt[jj] = qs * fexp(g - gm); qi[jj] = qs * fexp(g); kt[jj] = kk[jj] * fexp(gm - g); } else { qt[jj] = 0.f; qi[jj] = 0.f; kt[jj] = 0.f; }
            ks[jj] = (MODE & 1) ? kk[jj] * fexp(gl - g) : 0.f;
        }
        const unsigned c1 = 2u * (unsigned)(tid & 7);
#define LA_ST2(T, ST, AR) do { u32x4 p_; p_[0] = pk2(AR[0], AR[1]); p_[1] = pk2(AR[2], AR[3]); p_[2] = pk2(AR[4], AR[5]); p_[3] = pk2(AR[6], AR[7]); *(LAS u32x4*)((T) + (ST) * m + 16u * c1) = p_; \
            u32x4 r_; r_[0] = pk2(AR[8], AR[9]); r_[1] = pk2(AR[10], AR[11]); r_[2] = pk2(AR[12], AR[13]); r_[3] = pk2(AR[14], AR[15]); *(LAS u32x4*)((T) + (ST) * m + 16u * c1 + 16u) = r_; } while (0)
        if (MODE & 2) { LA_ST2(QT, RS, qt); LA_ST2(QI, RS, qi); LA_ST2(KT, RS, kt); }
        if (MODE & 1) { LA_ST2(KS, TRS, ks); }
        *(LAS u32x4*)(VV + TRS * m + 16u * c1) = vw0; *(LAS u32x4*)(VV + TRS * m + 16u * c1 + 16u) = vw1;
        if ((MODE == 1) && tid < 128) st_wt(a.hdec + tid, fexp(G[63 * 128 + tid]));
    }
    const bool qpub = a.pub_prev && !pubdone;
    if (qpub) asm volatile("s_waitcnt vmcnt(0)" ::: "memory");
    TrItem cvt; f32x4 cvv[16];
    const bool cvon = conv_list_setup(cvt, cvx, a.layer, a.cv_wi >= 0 ? a.cv_wi + w : -1, lane);
    if (a.cv_wi >= 0) tr_load(cvt, cvv); else { for (int i = 0; i < 16; ++i) cvv[i] = (f32x4){0.f, 0.f, 0.f, 0.f}; }
    __syncthreads();
    if (qpub && tid == 0) __hip_atomic_fetch_add(a.pub_prev, 1u, __ATOMIC_RELAXED, __HIP_MEMORY_SCOPE_AGENT);
    if (MODE & 1) {
#pragma unroll
        for (int i = 0; i < 2; ++i) {
            const int tt = 2 * w + i, di = tt >> 2, ei = tt & 3;
            f32x16 acc = zero16();
            if (MODE == 1) {
#pragma unroll
                for (int s = 0; s < 4; ++s) acc = MFMA32(tr8(VV, 16 * s + 8 * h, 16 * s + 8 * h + 4, ei, lane), tr8(KS, 16 * s + 8 * h, 16 * s + 8 * h + 4, di, lane), acc);
                const bool odd = (r & 1) != 0;
#pragma unroll
                for (int g2 = 0; g2 < 8; ++g2) {
                    const float m0 = acc[2 * g2], m1 = acc[2 * g2 + 1];
                    const float rv = __shfl_xor(odd ? m0 : m1, 1);
                    const unsigned word = odd ? pk2(rv, m1) : pk2(m0, rv);
                    const int e = 32 * ei + crow(2 * g2, h) + (odd ? 1 : 0);
                    st_wt32((unsigned*)(a.dSout + e * 128 + 32 * di + (r & ~1)), word);
                }
            } else {
#pragma unroll
                for (int s = 0; s < 4; ++s) acc = MFMA32(tr8(KS, 16 * s + 8 * h, 16 * s + 8 * h + 4, di, lane), tr8(VV, 16 * s + 8 * h, 16 * s + 8 * h + 4, ei, lane), acc);
#pragma unroll
                for (int g = 0; g < 16; ++g) { const int d = 32 * di + crow(g, h); const float dec = (MIXER == 0) ? decay_s : fexp(G[63 * 128 + d]);
                    a.Sout[d * 128 + 32 * ei + r] = dec * a.Sprev[d * 128 + 32 * ei + r] + acc[g]; }
            }
        }
    }
    if (MODE & 2) {
        const int li = w >> 2, ei = w & 3;
        f32x16 O = zero16();
        if (MODE == 3) {
            const float* sp0 = a.Sprev + (8 * h) * 128 + 32 * ei + r;
#pragma unroll
            for (int s = 0; s < 8; ++s)
#pragma unroll
                for (int j = 0; j < 8; ++j) sv[s][j] = sp0[(16 * s + j) * 128];
        }
#pragma unroll
        for (int s = 0; s < 8; ++s) {
            bf16x8 bop;
            if (MODE == 2) { u32x4 bw; bw.x = (unsigned)svq[s][0]; bw.y = (unsigned)(svq[s][0] >> 32); bw.z = (unsigned)svq[s][1]; bw.w = (unsigned)(svq[s][1] >> 32); bop = __builtin_bit_cast(bf16x8, bw); }
            else bop = pack8(sv[s][0], sv[s][1], sv[s][2], sv[s][3], sv[s][4], sv[s][5], sv[s][6], sv[s][7]);
            O = MFMA32(ld_row(QI, 32 * li + r, s, h), bop, O);
        }
        for (int mi = 0; mi <= li; ++mi) {
            f32x16 X = zero16();
#pragma unroll
            for (int s = 0; s < 8; ++s) X = MFMA32(ld_row(KT, 32 * mi + r, s, h), ld_row(QT, 32 * li + r, s, h), X);
            if (mi == li) {
#pragma unroll
                for (int g = 0; g < 16; ++g) X[g] = (crow(g, h) <= r) ? X[g] : 0.f;
            }
            const bf16x8 pa0 = pack8(X[0], X[1], X[2], X[3], X[4], X[5], X[6], X[7]), pa1 = pack8(X[8], X[9], X[10], X[11], X[12], X[13], X[14], X[15]);
            O = MFMA32(pa0, tr8(VV, 32 * mi + 4 * h, 32 * mi + 8 + 4 * h, ei, lane), O);
            O = MFMA32(pa1, tr8(VV, 32 * mi + 16 + 4 * h, 32 * mi + 24 + 4 * h, ei, lane), O);
        }
        __syncthreads();
#pragma unroll
        for (int g = 0; g < 16; ++g) G[(32 * li + crow(g, h)) * 128 + 32 * ei + r] = O[g];
        __syncthreads();
        const int l = tid >> 3, e0 = 16 * (tid & 7);
        float o[16]; float ss = 0.f;
#pragma unroll
        for (int q4 = 0; q4 < 4; ++q4) { const f32x4 t = *(LAS const f32x4*)(G + l * 128 + e0 + 4 * q4); o[4 * q4] = t[0]; o[4 * q4 + 1] = t[1]; o[4 * q4 + 2] = t[2]; o[4 * q4 + 3] = t[3];
            ss += (t[0] * t[0] + t[1] * t[1]) + (t[2] * t[2] + t[3] * t[3]); }
        ss += __shfl_xor(ss, 1); ss += __shfl_xor(ss, 2); ss += __shfl_xor(ss, 4);
        const float rstd = __builtin_amdgcn_rsqf(ss * (1.0f / 128.0f) + EPS);
        float y[16];
#pragma unroll
        for (int jj = 0; jj < 16; ++jj) {
            const unsigned wg = (jj < 8) ? gw0[jj >> 1] : gw1[(jj - 8) >> 1];
            const float gt = (jj & 1) ? bfhi(wg) : bflo(wg);
            const float sg = sigmoidf_(gt);
            const float gate = (MIXER == 0) ? gt * sg : sg;
            y[jj] = o[jj] * rstd * ngv[jj >> 2][jj & 3] * gate;
        }
        u32x4 p0, p1; p0.x = pk2(y[0], y[1]); p0.y = pk2(y[2], y[3]); p0.z = pk2(y[4], y[5]); p0.w = pk2(y[6], y[7]);
        p1.x = pk2(y[8], y[9]); p1.y = pk2(y[10], y[11]); p1.z = pk2(y[12], y[13]); p1.w = pk2(y[14], y[15]);
        bf16* mo = a.mixo + (size_t)l * 2048 + e0;
        *(u32x4*)(mo) = p0; *(u32x4*)(mo + 8) = p1;
    }
    if (cvon) tr_store(cvt, cvv);
#undef LA_ST
#undef LA_ST2
}
template <int WIN>
DI void pool_win(const float (&u)[31], LAS unsigned char* P, const int seg, const int c, const bool prompt, const int row0) {
#pragma unroll
    for (int k = 0; k < 16; ++k) {
        float s = 0.f;
#pragma unroll
        for (int j = 0; j < WIN; ++j) s += u[k + 15 - j];
        const int t = 16 * seg + k, pos = prompt ? (row0 + t) : (PAST + t);
        const float cnt = (float)((pos + 1 < WIN) ? pos + 1 : WIN);
        const float p = s / cnt - u[k + 15];
        *(LAS unsigned short*)(P + RS * t + 2 * c) = (unsigned short)(pk2(p, 0.f) & 0xffffu);
    }
}
DI void pool_item(LAS unsigned char* lds, const bf16* z, const float* state_pool_l, const bf16* pwt_l, bf16* mix, const int ti, const int g, const ConvCtx& cvx, const int cv_l, const int cv_wi, const int tid_in) {
    int tid = tid_in; asm volatile("" : "+v"(tid));
    const int lane = tid & 63, w = __builtin_amdgcn_readfirstlane(tid >> 6), r = lane & 31, h = lane >> 5;
    LAS float* U = (LAS float*)lds;
    LAS unsigned char* P = lds + 49152;
    const bool prompt = ti < 128; const int row0 = prompt ? 64 * ti : 8192 + 64 * (ti - 128);
    TrItem cvt; f32x4 cvv[16];
    const bool cvon = conv_list_setup(cvt, cvx, cv_l, cv_wi >= 0 ? cv_wi + w : -1, lane);
    if (cv_wi >= 0) tr_load(cvt, cvv); else { for (int i = 0; i < 16; ++i) cvv[i] = (f32x4){0.f, 0.f, 0.f, 0.f}; }
    for (int n = tid; n < 79 * 16; n += 512) {
        const int j = n >> 4, ch = n & 15; float v[8];
        const int trow = row0 + j - 15;
        if (j >= 15 || (prompt && trow >= 0)) {
            const u32x4 t = *(const u32x4*)(z + (size_t)trow * 6144 + 7 * 512 + 128 * g + 8 * ch);
            v[0] = bflo(t.x); v[1] = bfhi(t.x); v[2] = bflo(t.y); v[3] = bfhi(t.y); v[4] = bflo(t.z); v[5] = bfhi(t.z); v[6] = bflo(t.w); v[7] = bfhi(t.w);
        } else if (!prompt) {
            const float* sp = state_pool_l + ((size_t)(ti - 128) * 15 + j) * 512 + 128 * g + 8 * ch;
            const f32x4 a = *(const f32x4*)sp, b = *(const f32x4*)(sp + 4);
            v[0] = a[0]; v[1] = a[1]; v[2] = a[2]; v[3] = a[3]; v[4] = b[0]; v[5] = b[1]; v[6] = b[2]; v[7] = b[3];
        } else {
#pragma unroll
            for (int i = 0; i < 8; ++i) v[i] = 0.f;
        }
        *(LAS f32x4*)(U + j * 128 + 8 * ch) = (f32x4){v[0], v[1], v[2], v[3]}; *(LAS f32x4*)(U + j * 128 + 8 * ch + 4) = (f32x4){v[4], v[5], v[6], v[7]};
    }
    __syncthreads();
    {   const int c = tid & 127, seg = tid >> 7;
        float u[31];
#pragma unroll
        for (int i = 0; i < 31; ++i) u[i] = U[(16 * seg + i) * 128 + c];
        switch (g) {
            case 0: pool_win<2>(u, P, seg, c, prompt, row0); break;
            case 1: pool_win<4>(u, P, seg, c, prompt, row0); break;
            case 2: pool_win<8>(u, P, seg, c, prompt, row0); break;
            default: pool_win<16>(u, P, seg, c, prompt, row0); break;
        }
    }
    __syncthreads();
    const int ti2 = w >> 2, di = w & 3;
    f32x16 acc = zero16();
    const bf16* wb = pwt_l + ((size_t)g * 128 + 32 * di + r) * 128 + 8 * h;
#pragma unroll
    for (int s = 0; s < 8; ++s) acc = MFMA32(ld_row(P, 32 * ti2 + r, s, h), *(const bf16x8*)(wb + 16 * s), acc);
#pragma unroll
    for (int i = 0; i < 16; ++i) mix[(size_t)(row0 + 32 * ti2 + crow(i, h)) * 2048 + 1024 + 128 * g + 32 * di + r] = (unsigned short)(pk2(acc[i], 0.f) & 0xffffu);
    if (cvon) tr_store(cvt, cvv);
}

DI float wave_sum(float v) {
#pragma unroll
    for (int o = 1; o < 64; o <<= 1) v += __shfl_xor(v, o);
    return v;
}
constexpr int NWAVES_ = 8;
DI void splitk_fixup(bf16* XB, float* ssq, const bf16* slab, const pg8::SplitOrder& S, const int bx, const int tid_in) {
    int tid = tid_in; asm volatile("" : "+v"(tid));
    const int lane = tid & 63, wave = tid >> 6;
    for (int it0 = (bx * NWAVES_ + wave) * 4; it0 < 64 * 256; it0 += 256 * NWAVES_ * 4) {
        u32x2 rr[4], p0[4], p1[4], p2[4], p3[4]; size_t offs[4]; int rows[4], pns[4];
#pragma unroll
        for (int q = 0; q < 4; ++q) {
            const int it = it0 + q, s = it >> 8, r = it & 255;
            pg8::Unit u; S.tile_of(256 + s, u);
            const int row = u.pm * 256 + r, col = u.pn * 256 + 4 * lane;
            const size_t off = (size_t)row * 2048 + col; offs[q] = off; rows[q] = row; pns[q] = u.pn;
            const bf16* sp = slab + ((size_t)(s * 4) * 256 + r) * 256 + 4 * lane;
            rr[q] = *(const u32x2*)(XB + off); p0[q] = *(const u32x2*)(sp); p1[q] = *(const u32x2*)(sp + 65536); p2[q] = *(const u32x2*)(sp + 2 * 65536); p3[q] = *(const u32x2*)(sp + 3 * 65536);
        }
#pragma unroll
        for (int q = 0; q < 4; ++q) {
            const f32x4 rf = {bflo(rr[q].x), bfhi(rr[q].x), bflo(rr[q].y), bfhi(rr[q].y)};
#define F4_(v) ((f32x4){bflo((v).x), bfhi((v).x), bflo((v).y), bfhi((v).y)})
            const f32x4 o = rf + (((F4_(p0[q]) + F4_(p1[q])) + F4_(p2[q])) + F4_(p3[q]));
#undef F4_
            u32x2 w; w.x = pk2(o[0], o[1]); w.y = pk2(o[2], o[3]); *(u32x2*)(XB + offs[q]) = w;
            float qq = (o[0] * o[0] + o[1] * o[1]) + (o[2] * o[2] + o[3] * o[3]);
            qq += __shfl_xor(qq, 1); qq += __shfl_xor(qq, 2); qq += __shfl_xor(qq, 4); qq += __shfl_xor(qq, 8);
            if ((lane & 15) == 0) ssq[(size_t)rows[q] * 32 + pns[q] * 4 + (lane >> 4)] = qq;
        }
    }
}
constexpr int NWAVES = 8;
#ifndef G1_WGM
#define G1_WGM 8
#endif
#ifndef G3_WGM
#define G3_WGM 8
#endif
#ifndef REP_M1_MASK
#define REP_M1_MASK 63
#endif
#define M1_RUN(bit) (rep == 0 || (REP_M1_MASK & (bit)))
#ifndef GEMM_ALIGN
#define GEMM_ALIGN true
#endif
#ifndef GEMM_SP2
#define GEMM_SP2 true
#endif
#ifndef REP_P0
#define REP_P0 1
#endif
#ifndef REP_G1
#define REP_G1 1
#endif
#ifndef REP_M1
#define REP_M1 1
#endif
#ifndef REP_M3
#define REP_M3 1
#endif
#ifndef REP_G3
#define REP_G3 1
#endif
constexpr int NPHASE = 2 + 7 * NL;
struct Args { const float* in[19]; float* out; unsigned char* ws; int ph_lo, ph_hi; };
static_assert(sizeof(Args) == 19 * 8 + 8 + 8 + 8, "Args has no padding holes");

__global__ void __launch_bounds__(NWAVES * 64, 2) fwd(Args args) {
    extern __shared__ __attribute__((aligned(16))) unsigned char lds_raw[];
    LAS unsigned char* lds = (LAS unsigned char*)lds_raw;
    volatile LAS unsigned* MISC = (volatile LAS unsigned*)(lds + LDS_CTL_OFF);
    const int tid0 = threadIdx.x;
#define PHASE_TID() int tid = tid0; asm volatile("" : "+v"(tid)); const int lane = tid & 63, wave = __builtin_amdgcn_readfirstlane(tid >> 6); (void)lane; (void)wave
    const int G = gridDim.x, bx = blockIdx.x;
    unsigned char* ws = args.ws;
    unsigned* ctl = (unsigned*)(ws + WS_CTL);
    float* ssq = (float*)(ws + WS_SSQ);
    bf16* WinT = (bf16*)(ws + WS_WIN); bf16* WoutT = (bf16*)(ws + WS_WOUT); bf16* WupT = (bf16*)(ws + WS_WUP); bf16* WdnT = (bf16*)(ws + WS_WDN);
    bf16* PoolWT = (bf16*)(ws + WS_POOLW); bf16* XB = (bf16*)(ws + WS_XB); bf16* Z = (bf16*)(ws + WS_Z);
    bf16* MIX = (bf16*)(ws + WS_MIX); bf16* UU = (bf16*)(ws + WS_U); bf16* DSB = (bf16*)(ws + WS_DS); float* HDEC = (float*)(ws + WS_HDEC); bf16* SLAB = (bf16*)(ws + WS_SLAB); float* LB = (float*)(ws + WS_LB); float* ONES = (float*)(ws + WS_LB + 65536);
    const float* x_prompt = args.in[0]; const float* x_sample = args.in[1]; const float* state_ret = args.in[2]; const float* cache_k = args.in[3]; const float* cache_v = args.in[4];
    const float* state_pool = args.in[5]; const float* state_hgrn = args.in[6]; const float* norm1_g = args.in[7]; const float* w_in = args.in[8]; const float* ret_norm_g = args.in[9];
    const float* pool_w = args.in[10]; const float* pool_scale = args.in[11]; const float* hg_lb = args.in[12]; const float* hg_norm_g = args.in[13]; const float* w_out = args.in[14];
    const float* norm2_g = args.in[15]; const float* w_up = args.in[16]; const float* w_down = args.in[17]; const float* final_g = args.in[18];
    float* out = args.out;
    const ConvCtx cvx{w_in, w_out, w_up, w_down, norm1_g, norm2_g, ONES, WinT, WoutT, WupT, WdnT};

    for (int u = tid0; u < (LDS_BYTES - LDS_CTL_OFF) / 4; u += NWAVES * 64) ((LAS unsigned*)(lds + LDS_CTL_OFF))[u] = 0u;
    __syncthreads();
#if MK_PER_PHASE
#define GRID_BAR() do { } while (0)
#else
    XcdBarrier bar = xcd_barrier_post(ctl + CW_BAR, MISC + 8);
#ifndef REP_BAR
#define REP_BAR 1
#endif
#define GRID_BAR() do { for (int rb_ = 0; rb_ < REP_BAR; ++rb_) xcd_barrier(bar); } while (0)
#endif
    volatile LAS int* wq_slot = (volatile LAS int*)(MISC + 16);
    const int lo = args.ph_lo, hi = args.ph_hi;
#define IN(k) (lo <= (k) && (k) < hi)
#define SEAM(k) do { if (IN(k) && IN((k) + 1)) GRID_BAR(); } while (0)

    if (IN(0)) for (int rep = 0; rep < REP_P0; ++rep) {
        PHASE_TID();
        const int gw = bx * NWAVES + wave, NGW = G * NWAVES;
        for (int it = 2 * gw; it < CV_IN; it += 2 * NGW) conv_wave_pair(w_in, w_out, w_up, w_down, norm1_g, norm2_g, ONES, WinT, WoutT, WupT, WdnT, 0, it, 0, it + 1, lane);
        for (int i = bx * 512 + tid; i < NL * 4 * 128 * 128; i += G * 512) {
            const int c = i & 127, d = (i >> 7) & 127, g = (i >> 14) & 3, l = i >> 16;
            PoolWT[i] = (unsigned short)(pk2(pool_w[(((size_t)l * 4 + g) * 128 + c) * 128 + d] * pool_scale[l * 512 + 128 * g + d], 0.f) & 0xffffu);
        }
        for (int i = bx * 512 + tid; i < DFF; i += G * 512) ONES[i] = 1.0f;
        for (int i = bx * 512 + tid; i < 512; i += G * 512) {
            const float b0 = hg_lb[i], b1 = hg_lb[512 + i], b2 = hg_lb[1024 + i], b3 = hg_lb[1536 + i];
            const float mx = fmaxf(fmaxf(b0, b1), fmaxf(b2, b3));
            const float e0 = fexp(b0 - mx), e1 = fexp(b1 - mx), e2 = fexp(b2 - mx), e3 = fexp(b3 - mx), den = (e0 + e1) + (e2 + e3);
            LB[i] = 0.f; LB[512 + i] = e1 / den; LB[1024 + i] = (e1 + e2) / den; LB[1536 + i] = ((e1 + e2) + e3) / den;
        }
        for (int m = gw; m < MR; m += NGW) {
            const float* xr = (m < TP) ? x_prompt + (size_t)m * DM : x_sample + (size_t)(m - TP) * DM;
            float s = 0.f;
#pragma unroll
            for (int j = 0; j < 8; ++j) { const f32x4 v = *(const f32x4*)(xr + 4 * lane + 256 * j); s += (v[0] * v[0] + v[1] * v[1]) + (v[2] * v[2] + v[3] * v[3]);
                u32x2 p; p.x = pk2(v[0], v[1]); p.y = pk2(v[2], v[3]); *(u32x2*)(XB + (size_t)m * DM + 4 * lane + 256 * j) = p; }
            s = wave_sum(s);
            if (lane < 32) ssq[(size_t)m * 32 + lane] = (lane == 0) ? s : 0.f;
        }
    }
    SEAM(0);

    for (int l = 0; l < NL; ++l) {
        const int pb = 1 + 7 * l;
        int bxl = bx; asm volatile("" : "+s"(bxl));
        float* ssq1 = ssq + (size_t)(2 * l) * MR * 32; float* ssq2 = ssq + (size_t)(2 * l + 1) * MR * 32; float* ssq3 = ssq + (size_t)(2 * l + 2) * MR * 32;
        if (IN(pb)) for (int rep = 0; rep < REP_G1; ++rep) {
            pg8::Gemm g{XB, WinT + (size_t)l * DIN * DM, MR, DIN, DM}; pg8::StaticOrder S; S.init(MR, DIN, G, bxl, DM, G1_WGM);
            pg8::EpiIn E{Z, ssq1,
                         out + O_POOLP + (size_t)l * 15 * 512, out + O_POOLS + (size_t)l * NB * 15 * 512};
            pg8::gemm_phase<pg8::EpiIn, pg8::StaticOrder, GEMM_ALIGN, GEMM_SP2>(lds, g, S, E);
        }
        SEAM(pb);
        if (IN(pb + 1)) {
            PHASE_TID();
            unsigned* qctr = ctl + CW_Q + 64 * (2 * l);
            unsigned* dep = ctl + CW_DEP + (l * 16) * 64; unsigned* tmo = ctl;
            int wq_pre = wq_claim(qctr), wq_par = 0;
            unsigned* pend = nullptr;
            unsigned seen = 0u;
            for (;;) {
                const int it = wq_next(qctr, wq_slot, wq_pre, wq_par);
                if (it >= 3328) break;
                if ((it >= 256 && it < 1280) || (it >= 1408 && it < 1664) || it >= 2304) {
                    LaArgs a; int mixer; a.tmo = tmo; a.dep_done = nullptr; a.dep_need = nullptr; a.cv_wi = -1; a.pub_prev = pend;
                    if (it < 1280) { const int k = it - 256; mixer = k >> 9; const int rem = k & 511, hh = rem >> 7, c = rem & 127;
                        a.z = Z + (size_t)(64 * c) * DIN; a.h = hh; a.pos0 = 64 * c; a.mode = 1; a.prompt = 1;
                        a.Sprev = nullptr; a.SpT = nullptr; a.dSout = DSB + ((size_t)(mixer * 4 + hh) * 128 + c) * 16384; a.Sout = nullptr; a.hdec = HDEC + ((size_t)hh * 128 + c) * 128;
                        a.mixo = nullptr; a.cv_wi = 3072 + 8 * k; a.dep_done = dep + (mixer * 4 + hh) * 64;
                    } else if (it < 1664) { const int k = it - 1408; mixer = k >> 7; const int rem = k & 127, b = rem >> 2, hh = rem & 3;
                        a.z = Z + (size_t)(TP + 64 * b) * DIN; a.h = hh; a.pos0 = PAST; a.mode = 3; a.prompt = 0;
                        a.Sprev = (mixer == 0 ? state_ret : state_hgrn) + ((size_t)(l * NB + b) * 4 + hh) * 16384; a.SpT = nullptr; a.dSout = nullptr;
                        a.Sout = out + (mixer == 0 ? O_RETS : O_HGS) + ((size_t)(l * NB + b) * 4 + hh) * 16384; a.hdec = nullptr;
                        a.mixo = MIX + (size_t)(TP + 64 * b) * DM + (mixer == 0 ? 0 : 1536) + hh * 128;
                    } else { const int k = it - 2304; mixer = k >> 9; const int rem = k & 511, hh = rem >> 7, c = rem & 127;
                        a.z = Z + (size_t)(64 * c) * DIN; a.h = hh; a.pos0 = 64 * c; a.mode = 2; a.prompt = 1;
                        a.Sprev = nullptr; a.SpT = DSB + ((size_t)(mixer * 4 + hh) * 128 + c) * 16384; a.dSout = nullptr; a.Sout = nullptr; a.hdec = nullptr;
                        a.mixo = MIX + (size_t)(64 * c) * DM + (mixer == 0 ? 0 : 1536) + hh * 128;
                        const int mh = mixer * 4 + hh; a.dep_need = ((seen >> mh) & 1u) ? nullptr : dep + (8 + mh) * 64; seen |= 1u << mh;
                    }
                    a.ng = (mixer == 0 ? ret_norm_g : hg_norm_g) + l * 512 + a.h * 128; a.lbsrc = LB + l * 512; a.layer = l;
                    if (it < 1280) { if (mixer == 0) la_item<0, 1>(lds, a, cvx, tid); else la_item<1, 1>(lds, a, cvx, tid); }
                    else if (it < 1664) { if (mixer == 0) la_item<0, 3>(lds, a, cvx, tid); else la_item<1, 3>(lds, a, cvx, tid); }
                    else { if (mixer == 0) la_item<0, 2>(lds, a, cvx, tid); else la_item<1, 2>(lds, a, cvx, tid); }
                    pend = a.dep_done;
                } else if (it < 256) {
                    if (pend) { dep_publish(pend); pend = nullptr; }
                    const int k = it; SbArgs a;
                    if (k < 128) { const int b = k >> 2, hh = k & 3; const size_t zr = (size_t)(TP + 64 * b) * DIN;
                        a.zq = Z + zr + 4 * 512 + hh * 128; a.zk = Z + zr + 5 * 512 + hh * 128; a.zv = Z + zr + 6 * 512 + hh * 128;
                        a.kc = cache_k + ((size_t)(l * NB + b) * PAST) * 512 + hh * 128; a.vc = cache_v + ((size_t)(l * NB + b) * PAST) * 512 + hh * 128;
                        a.nf32 = 64; a.t_hi = 64; a.qpos0 = PAST; a.nqw = 2; a.mixo = MIX + (size_t)(TP + 64 * b) * DM + 512 + hh * 128;
                        a.ok = out + O_SBKS + ((size_t)l * 2048 + 64 * b) * 512 + hh * 128; a.ovd = (int)(O_SBVS - O_SBKS); a.own_lo = 64;
                    } else { const int k2 = k - 128, qi = 31 - (k2 >> 2), hh = k2 & 3;
                        a.zq = Z + (size_t)(256 * qi) * DIN + 4 * 512 + hh * 128; a.zk = Z + 5 * 512 + hh * 128; a.zv = Z + 6 * 512 + hh * 128;
                        a.kc = cache_k; a.vc = cache_v; a.nf32 = 0; a.t_hi = 4 * qi + 3; a.qpos0 = 256 * qi; a.nqw = 8; a.mixo = MIX + (size_t)(256 * qi) * DM + 512 + hh * 128;
                        a.ok = out + O_SBKP + (size_t)l * TP * 512 + hh * 128; a.ovd = (int)(O_SBVP - O_SBKP); a.own_lo = 4 * qi;
                    }
                    sb_item(lds, a, cvx, l, (k < 128) ? 24 * k : -1, tid);
                } else if (it < 1408) {
                    int tq = tid; asm volatile("" : "+v"(tq));
                    const int s = it - 1280, mh = s >> 4, mixer = mh >> 2, hh = mh & 3, pidx = (s & 15) * 512 + tq, d = (2 * pidx) & 127, e = (2 * pidx) >> 7;
                    if (pend) { dep_publish(pend); pend = nullptr; }
                    dep_wait_sc1(dep + mh * 64, 128u, tmo);
                    unsigned* base = (unsigned*)DSB + (size_t)mh * 128 * 8192 + pidx;
                    const float dret = fexp2(64.0f * flog2(1.0f - fexp2(-5.0f - (float)hh)));
                    LAS float* H = (LAS float*)lds;
                    if (mixer == 1) {
                        const unsigned long long* hsrc = (const unsigned long long*)(HDEC + (size_t)hh * 16384);
#pragma unroll
                        for (int i = 0; i < 16; ++i) { const unsigned long long v = ld_wt64(hsrc + tq + 512 * i); *(LAS unsigned long long*)(H + 2 * (tq + 512 * i)) = v; }
                        __syncthreads();
                    }
                    float st0 = 0.f, st1 = 0.f;
                    for (int c0 = 0; c0 < 128; c0 += 64) {
                        unsigned t[64];
#pragma unroll
                        for (int c = 0; c < 64; ++c) t[c] = ld_wt32(base + (size_t)(c0 + c) * 8192);
                        if (mixer == 0) {
#pragma unroll
                            for (int c = 0; c < 64; ++c) { st_wt32(base + (size_t)(c0 + c) * 8192, pk2(st0, st1)); st0 = dret * st0 + bflo(t[c]); st1 = dret * st1 + bfhi(t[c]); }
                        } else {
#pragma unroll
                            for (int c = 0; c < 64; ++c) { st_wt32(base + (size_t)(c0 + c) * 8192, pk2(st0, st1)); const float dc0 = H[(c0 + c) * 128 + d], dc1 = H[(c0 + c) * 128 + d + 1];
                                st0 = dc0 * st0 + bflo(t[c]); st1 = dc1 * st1 + bfhi(t[c]); }
                        }
                    }
                    float* fo = out + (mixer == 0 ? O_RETP : O_HGP) + ((size_t)l * 4 + hh) * 16384;
                    fo[d * 128 + e] = st0; fo[(d + 1) * 128 + e] = st1;
                    pend = dep + (8 + mh) * 64;
                } else {
                    const int k = it - 1664;
                    if (pend) { dep_publish(pend); pend = nullptr; }
                    pool_item(lds, Z, state_pool + (size_t)l * NB * 15 * 512, PoolWT + (size_t)l * 4 * 128 * 128, MIX, k >> 2, k & 3, cvx, l, (k < 128) ? 11264 + 8 * k : -1, tid);
                }
            }
            if (pend) dep_publish(pend);
        }
        SEAM(pb + 1);
        if (IN(pb + 4)) {
            pg8::Gemm g{MIX, WoutT + (size_t)l * DM * DM, MR, DM, DM};
            pg8::EpiRes E{XB, ssq2, SLAB, bxl >> 2};
            if (G == 256) { pg8::SplitOrder S; S.init(MR, DM, G, bxl, DM, 5); pg8::gemm_phase<pg8::EpiRes, pg8::SplitOrder, GEMM_ALIGN, GEMM_SP2>(lds, g, S, E);
                GRID_BAR(); splitk_fixup(XB, ssq2, SLAB, S, bxl, tid0); }
            else { pg8::StaticOrder S; S.init(MR, DM, G, bxl, DM); pg8::gemm_phase<pg8::EpiRes, pg8::StaticOrder, GEMM_ALIGN, GEMM_SP2>(lds, g, S, E); }
        }
        SEAM(pb + 4);
        if (IN(pb + 5)) for (int rep = 0; rep < REP_G3; ++rep) {
            if (rep) GRID_BAR();
            pg8::Gemm g{XB, WupT + (size_t)l * DFF * DM, MR, DFF, DM}; pg8::StaticOrder S; S.init(MR, DFF, G, bxl, DM, G3_WGM);
            pg8::EpiUp E{UU, ssq2, DFF};
            pg8::gemm_phase<pg8::EpiUp, pg8::StaticOrder, GEMM_ALIGN, GEMM_SP2>(lds, g, S, E);
        }
        SEAM(pb + 5);
        if (IN(pb + 6)) {
            pg8::Gemm g{UU, WdnT + (size_t)l * DM * DFF, MR, DM, DFF};
            pg8::EpiRes E{XB, ssq3, SLAB, bxl >> 2};
            if (G == 256) { pg8::SplitOrder S; S.init(MR, DM, G, bxl, DFF, 5); pg8::gemm_phase<pg8::EpiRes, pg8::SplitOrder, GEMM_ALIGN, GEMM_SP2>(lds, g, S, E);
                GRID_BAR(); splitk_fixup(XB, ssq3, SLAB, S, bxl, tid0); }
            else { pg8::StaticOrder S; S.init(MR, DM, G, bxl, DFF); pg8::gemm_phase<pg8::EpiRes, pg8::StaticOrder, GEMM_ALIGN, GEMM_SP2>(lds, g, S, E); }
        }
        SEAM(pb + 6);
    }
    if (IN(NPHASE - 1)) {
        PHASE_TID();
        const float* sf = ssq + (size_t)(2 * NL) * MR * 32;
        const int gw = bx * NWAVES + wave, NGW = G * NWAVES;
        for (int m = gw; m < MR; m += NGW) {
            const float sq = wave_sum(lane < 32 ? sf[(size_t)m * 32 + lane] : 0.f);
            const float rs = __builtin_amdgcn_rsqf(sq * (1.0f / 2048.0f) + EPS);
            const bf16* xr = XB + (size_t)m * DM; float* yr = out + O_Y + (size_t)m * DM;
            u32x4 xv[4];
#pragma unroll
            for (int j = 0; j < 4; ++j) xv[j] = *(const u32x4*)(xr + 8 * lane + 512 * j);
#pragma unroll
            for (int j = 0; j < 4; ++j) { const f32x4 g0 = *(const f32x4*)(final_g + 8 * lane + 512 * j), g1 = *(const f32x4*)(final_g + 8 * lane + 512 * j + 4);
                const f32x4 v0 = {bflo(xv[j].x), bfhi(xv[j].x), bflo(xv[j].y), bfhi(xv[j].y)}, v1 = {bflo(xv[j].z), bfhi(xv[j].z), bflo(xv[j].w), bfhi(xv[j].w)};
                *(f32x4*)(yr + 8 * lane + 512 * j) = v0 * rs * g0; *(f32x4*)(yr + 8 * lane + 512 * j + 4) = v1 * rs * g1; }
        }
    }
#undef IN
#undef SEAM
#undef GRID_BAR
}

extern "C" void kernel_launch(void* const* d_in, const int* in_sizes, int n_in, void* d_out, int out_size, void* d_ws, size_t ws_size, hipStream_t stream) {
    static int grid = 0;
    if (grid == 0) {
        if (n_in != 19 || (size_t)out_size != O_END || ws_size < WS_END) { fprintf(stderr, "kernel_launch: unexpected shapes: n_in %d out %d ws %zu (need %zu, %zu)\n", n_in, out_size, ws_size, (size_t)O_END, (size_t)WS_END); grid = -1; return; }
        int dev = 0, cus = 0, per_cu = 0;
        if (hipGetDevice(&dev) != hipSuccess || hipDeviceGetAttribute(&cus, hipDeviceAttributeMultiprocessorCount, dev) != hipSuccess) { grid = -1; return; }
        if (hipFuncSetAttribute((const void*)fwd, hipFuncAttributeMaxDynamicSharedMemorySize, LDS_BYTES) != hipSuccess) { fprintf(stderr, "kernel_launch: hipFuncSetAttribute failed\n"); grid = -1; return; }
        if (hipOccupancyMaxActiveBlocksPerMultiprocessor(&per_cu, (const void*)fwd, NWAVES * 64, LDS_BYTES) != hipSuccess || per_cu < 1) fprintf(stderr, "kernel_launch: occupancy query reports %d\n", per_cu);
        (void)hipGetLastError();
        grid = cus;
    }
    if (grid < 0) return;
    if (hipMemsetAsync((char*)d_ws + WS_CTL, 0, CTL_ZERO_BYTES, stream) != hipSuccess) { fprintf(stderr, "kernel_launch: memset failed\n"); return; }
    Args a{};
    for (int i = 0; i < 19; ++i) a.in[i] = (const float*)d_in[i];
    a.out = (float*)d_out; a.ws = (unsigned char*)d_ws;
#if MK_PER_PHASE
    for (int p = 0; p < NPHASE; ++p) { a.ph_lo = p; a.ph_hi = p + 1; hipLaunchKernelGGL(fwd, dim3(grid), dim3(NWAVES * 64), LDS_BYTES, stream, a); }
#else
    a.ph_lo = 0; a.ph_hi = NPHASE;
    hipLaunchKernelGGL(fwd, dim3(grid), dim3(NWAVES * 64), LDS_BYTES, stream, a);
#endif
    const hipError_t le = hipPeekAtLastError();
    if (le != hipSuccess) fprintf(stderr, "kernel_launch: launch failed: %s\n", hipGetErrorName(le));
}
```

```cpp
#include <hip/hip_runtime.h>
#include <cstdio>
#include <cstdint>
#ifndef MK_PER_PHASE
#define MK_PER_PHASE 0
#endif
namespace pg8 {
#define PG8_LAS __attribute__((address_space(3)))
typedef unsigned short bf16_t;
typedef short bf16x8 __attribute__((ext_vector_type(8)));
typedef float f32x4 __attribute__((ext_vector_type(4)));
typedef unsigned u32x4 __attribute__((ext_vector_type(4)));
constexpr int BM = 256, BK = 64, HALF = 128, HTB = HALF * BK * 2  , STAGE_BYTES = 8 * HTB, NXCD = 8, WGM = 8;

__host__ __device__ __forceinline__ int lds_byte(int r, int c) { const int st = (r >> 4) * 2 + (c >> 5), rr = r & 15, cc = c & 31, ob = rr * 64 + cc * 2; return st * 1024 + (ob ^ (((ob >> 9) & 1) << 5)); }
__host__ __device__ __forceinline__ void stage_rc(int b, int& R, int& C) { const int st = b / 1024, sb = b % 1024, swz = sb ^ (((sb >> 9) & 1) << 5); R = (st >> 1) * 16 + swz / 64; C = (st & 1) * 32 + (swz % 64) / 2; }
__host__ __device__ __forceinline__ int perm32(int rho) { const int n = rho >> 4, i = rho & 15; return 8 * (i >> 2) + 4 * n + (i & 3); }

struct Unit { int pm, pn, koff, nt, part; };
struct Gemm { const bf16_t* A; const bf16_t* Bt; int M, N, K; };

struct StaticOrder {
    int nM, nN, nwg, G, c, ntk, wgm;
    __host__ __device__ void init(int M, int N, int G_, int c_, int K_, int wgm_ = WGM) { nM = M / BM; nN = N / BM; nwg = nM * nN; G = G_; c = c_; ntk = K_ / BK; wgm = wgm_; }
    __host__ __device__ void tile_of(int L, Unit& u) const {
        int wgid = L; { const int q = nwg / NXCD, r = nwg % NXCD, xcd = wgid % NXCD, off = wgid / NXCD; wgid = (xcd < r ? xcd * (q + 1) : r * (q + 1) + (xcd - r) * q) + off; }
        const int nig = wgm * nN, gid = wgid / nig, fm = gid * wgm, gsz = (nM - fm) < wgm ? (nM - fm) : wgm;
        u.pm = fm + ((wgid % nig) % gsz); u.pn = (wgid % nig) / gsz; }
    __host__ __device__ bool next(int i, Unit& u) const {
        const long L = (long)i * G + c; if (L >= nwg) return false;
        int wgid = (int)L; { const int q = nwg / NXCD, r = nwg % NXCD, xcd = wgid % NXCD, off = wgid / NXCD; wgid = (xcd < r ? xcd * (q + 1) : r * (q + 1) + (xcd - r) * q) + off; }
        const int nig = wgm * nN, gid = wgid / nig, fm = gid * wgm, gsz = (nM - fm) < wgm ? (nM - fm) : wgm;
        u.pm = fm + ((wgid % nig) % gsz); u.pn = (wgid % nig) / gsz; u.koff = 0; u.nt = ntk; u.part = -1; return true;
    }
    __device__ __forceinline__ void a_ready(const Unit&) const {}
    __device__ __forceinline__ void done(const Unit&) const {}
};
struct SameTileOrder : StaticOrder {
    int nun;
    __host__ __device__ bool next(int i, Unit& u) const { if (i >= nun) return false; u.pm = 0; u.pn = 0; u.koff = 0; u.nt = ntk; u.part = -1; return true; }
};
struct SplitOrder : StaticOrder {
    __host__ __device__ bool next(int i, Unit& u) const {
        if (i == 0) { tile_of(c, u); u.koff = 0; u.nt = ntk; u.part = -1; return true; }
        if (i == 1) { tile_of(G + (c >> 2), u); u.nt = ntk / 4; u.koff = (c & 3) * (ntk / 4) * BK * 2; u.part = c & 3; return true; }
        return false;
    }
};

__device__ __forceinline__ unsigned cvt_pk_bf16(float lo, float hi) { unsigned r; asm volatile("v_cvt_pk_bf16_f32 %0, %1, %2" : "=v"(r) : "v"(lo), "v"(hi)); return r; }
typedef float f32x2 __attribute__((ext_vector_type(2)));
typedef __bf16 bf16x2_t __attribute__((ext_vector_type(2)));
__device__ __forceinline__ unsigned pk2(float a, float b) { f32x2 v = {a, b}; bf16x2_t r = __builtin_convertvector(v, bf16x2_t); return __builtin_bit_cast(unsigned, r); }

struct EpiIn {
    static constexpr bool PERM = true, AFTER_DRAIN = false;
    bf16_t* Z; const float* ssq;
    float* pool_p; float* pool_s;
    __device__ __forceinline__ void operator()(const f32x4 (&acc)[2][2][4][2], const Unit& u, int wr, int wc, int fr, int fq) const {
        asm volatile("" : "+v"(fr), "+v"(fq));
        const int row0 = u.pm * BM + wr * 64 + fr, grp = u.pn >> 1;
        const int col0 = u.pn * BM + wc * 32 + 8 * fq, cg0 = (u.pn & 1) * 256 + wc * 32 + 8 * fq;
#pragma unroll
        for (int ai = 0; ai < 2; ++ai)
#pragma unroll
            for (int m = 0; m < 4; ++m) {
                const int row = row0 + ai * HALF + m * 16;
                float sq; { const f32x4 p0 = *(const f32x4*)(ssq + (size_t)row * 32 + 8 * fq), p1 = *(const f32x4*)(ssq + (size_t)row * 32 + 8 * fq + 4);
                    sq = ((p0[0] + p0[1]) + (p0[2] + p0[3])) + ((p1[0] + p1[1]) + (p1[2] + p1[3])); sq += __shfl_xor(sq, 16); sq += __shfl_xor(sq, 32); }
                const float rs = __builtin_amdgcn_rsqf(sq * (1.0f / 2048.0f) + 1e-6f);
                bf16_t* rowp = Z + (size_t)row * 6144 + col0;
#pragma unroll
                for (int bj = 0; bj < 2; ++bj) {
                    const f32x4 v0 = acc[ai][bj][m][0] * rs, v1 = acc[ai][bj][m][1] * rs;
                    u32x4 w; w.x = pk2(v0[0], v0[1]); w.y = pk2(v0[2], v0[3]); w.z = pk2(v1[0], v1[1]); w.w = pk2(v1[2], v1[3]);
                    *(u32x4*)(rowp + bj * HALF) = w;
                    const int cg = cg0 + bj * HALF;
                    if (grp == 7) {
                        if (u.pm < 32) { if (row >= 8177) { float* dst = pool_p + (size_t)(row - 8177) * 512 + cg; *(f32x4*)(dst) = v0; *(f32x4*)(dst + 4) = v1; } }
                        else { const int rsx = row - 8192, i = rsx & 63; if (i >= 49) { float* dst = pool_s + ((size_t)(rsx >> 6) * 15 + (i - 49)) * 512 + cg; *(f32x4*)(dst) = v0; *(f32x4*)(dst + 4) = v1; } }
                    }
                }
            }
    }
};
struct EpiRes {
    static constexpr bool PERM = true, AFTER_DRAIN = false;
    bf16_t* XB; float* ssq; bf16_t* slab; int slab_id;
    __device__ __forceinline__ void operator()(const f32x4 (&acc)[2][2][4][2], const Unit& u, int wr, int wc, int fr, int fq) const {
        asm volatile("" : "+v"(fr), "+v"(fq));
        if (u.part >= 0) {
            bf16_t* sp = slab + ((size_t)(slab_id * 4 + u.part) * 256 + wr * 64 + fr) * 256 + wc * 32 + 8 * fq;
#pragma unroll
            for (int ai = 0; ai < 2; ++ai)
#pragma unroll
                for (int m = 0; m < 4; ++m)
#pragma unroll
                    for (int bj = 0; bj < 2; ++bj) { const f32x4 a0 = acc[ai][bj][m][0], a1 = acc[ai][bj][m][1];
                        u32x4 w; w.x = pk2(a0[0], a0[1]); w.y = pk2(a0[2], a0[3]); w.z = pk2(a1[0], a1[1]); w.w = pk2(a1[2], a1[3]);
                        *(u32x4*)(sp + (size_t)(ai * HALF + m * 16) * 256 + bj * HALF) = w; }
            return;
        }
        const int row0 = u.pm * BM + wr * 64 + fr, col0 = u.pn * BM + wc * 32 + 8 * fq;
        u32x4 rc[2], rn[2];
        {   const size_t off = (size_t)row0 * 2048 + col0;
#pragma unroll
            for (int bj = 0; bj < 2; ++bj) rc[bj] = *(const u32x4*)(XB + off + bj * HALF); }
#pragma unroll
        for (int ai = 0; ai < 2; ++ai)
#pragma unroll
            for (int m = 0; m < 4; ++m) {
                const int row = row0 + ai * HALF + m * 16; const size_t off = (size_t)row * 2048 + col0; float s = 0.f;
                if (ai * 4 + m < 7) { const int g1 = ai * 4 + m + 1; const size_t offn = (size_t)(row0 + (g1 >> 2) * HALF + (g1 & 3) * 16) * 2048 + col0;
#pragma unroll
                    for (int bj = 0; bj < 2; ++bj) rn[bj] = *(const u32x4*)(XB + offn + bj * HALF); }
#pragma unroll
                for (int bj = 0; bj < 2; ++bj) {
                    const u32x4 r = rc[bj];
                    const f32x4 r0 = {__uint_as_float(r.x << 16), __uint_as_float(r.x & 0xffff0000u), __uint_as_float(r.y << 16), __uint_as_float(r.y & 0xffff0000u)};
                    const f32x4 r1 = {__uint_as_float(r.z << 16), __uint_as_float(r.z & 0xffff0000u), __uint_as_float(r.w << 16), __uint_as_float(r.w & 0xffff0000u)};
                    const f32x4 o0 = r0 + acc[ai][bj][m][0], o1 = r1 + acc[ai][bj][m][1];
                    s += ((o0[0] * o0[0] + o0[1] * o0[1]) + (o0[2] * o0[2] + o0[3] * o0[3])) + ((o1[0] * o1[0] + o1[1] * o1[1]) + (o1[2] * o1[2] + o1[3] * o1[3]));
                    u32x4 w; w.x = pk2(o0[0], o0[1]); w.y = pk2(o0[2], o0[3]); w.z = pk2(o1[0], o1[1]); w.w = pk2(o1[2], o1[3]);
                    *(u32x4*)(XB + off + bj * HALF) = w;
                }
                s += __shfl_xor(s, 16); s += __shfl_xor(s, 32);
                if (fq == 0) ssq[(size_t)row * 32 + u.pn * 4 + wc] = s;
#pragma unroll
                for (int bj = 0; bj < 2; ++bj) rc[bj] = rn[bj];
            }
    }
};
template <int PM = 0> struct EpiUpT {
    static constexpr bool PERM = true, AFTER_DRAIN = false;
    bf16_t* U; const float* ssq; int ldc;
    __device__ __forceinline__ void operator()(const f32x4 (&acc)[2][2][4][2], const Unit& u, int wr, int wc, int fr, int fq) const {
        asm volatile("" : "+v"(fr), "+v"(fq));
        const int row0 = u.pm * BM + wr * 64 + fr, col0 = u.pn * BM + wc * 32 + 8 * fq;
#pragma unroll
        for (int ai = 0; ai < 2; ++ai)
#pragma unroll
            for (int m = 0; m < 4; ++m) {
                const int row = row0 + ai * HALF + m * 16;
                float sq = 2048.f; if (!(PM & 1)) { const f32x4 p0 = *(const f32x4*)(ssq + (size_t)row * 32 + 8 * fq), p1 = *(const f32x4*)(ssq + (size_t)row * 32 + 8 * fq + 4);
                    sq = ((p0[0] + p0[1]) + (p0[2] + p0[3])) + ((p1[0] + p1[1]) + (p1[2] + p1[3])); sq += __shfl_xor(sq, 16); sq += __shfl_xor(sq, 32); }
                float rs = __builtin_amdgcn_rsqf(sq * (1.0f / 2048.0f) + 1e-6f);
                bf16_t* rowp = U + (size_t)row * ldc + col0;
#pragma unroll
                for (int bj = 0; bj < 2; ++bj) {
                    f32x4 v0 = acc[ai][bj][m][0] * rs, v1 = acc[ai][bj][m][1] * rs;
#pragma unroll
                    for (int j = 0; j < 4; ++j) { const float a = fmaxf(v0[j], 0.f), b = fmaxf(v1[j], 0.f); v0[j] = a * a; v1[j] = b * b; }
                    u32x4 w; w.x = pk2(v0[0], v0[1]); w.y = pk2(v0[2], v0[3]); w.z = pk2(v1[0], v1[1]); w.w = pk2(v1[2], v1[3]);
                    if (!(PM & 2)) *(u32x4*)(rowp + bj * HALF) = w; else asm volatile("" :: "v"(w));
                }
            }
    }
};
typedef EpiUpT<0> EpiUp;
template <class Epi, class Sched, bool ALIGN_EPI = false, bool SP2 = false>
__device__ __forceinline__ void gemm_phase(PG8_LAS unsigned char* lds, const Gemm g, const Sched& S, const Epi& E) {
    int tid = threadIdx.x; asm volatile("" : "+v"(tid));
    const int wid = __builtin_amdgcn_readfirstlane(tid >> 6), lane = tid & 63, wr = wid >> 2, wc = wid & 3, fr = lane & 15, fq = lane >> 4;
    const int K = g.K;
    unsigned voffA[2], voffB[2];
#pragma unroll
    for (int i = 0; i < 2; ++i) { int R, C; stage_rc(tid * 16 + i * 8192, R, C); const int Rb = Epi::PERM ? ((R & ~31) + perm32(R & 31)) : R;
        voffA[i] = (unsigned)(R * K + C) * 2u; voffB[i] = (unsigned)(Rb * K + C) * 2u; }
    const size_t kstep = (size_t)(BK * 2);
    const size_t hstep = (size_t)HALF * K * 2;
    const size_t tstep = 2 * hstep;
    const unsigned ldsw = (unsigned)wid * 1024u;
    const int aoff = lds_byte(wr * 64 + fr, fq * 8), boff = lds_byte(wc * 32 + fr, fq * 8);
#define PG8_SA(b, h) (((b) * 2 + (h)) * HTB)
#define PG8_SB(b, h) ((4 + (b) * 2 + (h)) * HTB)
#define PG8_STAGE(bufoff, gbase, voff) do { _Pragma("unroll") for (int _i = 0; _i < 2; ++_i) \
        __builtin_amdgcn_global_load_lds((const unsigned*)((const char*)(gbase) + (voff)[_i]), (PG8_LAS unsigned*)(lds + (bufoff) + ldsw + _i * 8192), 16, 0, 0); } while (0)
#define PG8_LDA(dst, b, h) do { _Pragma("unroll") for (int m = 0; m < 4; ++m) _Pragma("unroll") for (int k = 0; k < 2; ++k) dst[m][k] = *(const PG8_LAS bf16x8*)(lds + PG8_SA(b, h) + aoff + m * 2048 + k * 1024); } while (0)
#define PG8_LDB(dst, b, h) do { _Pragma("unroll") for (int n = 0; n < 2; ++n) _Pragma("unroll") for (int k = 0; k < 2; ++k) dst[n][k] = *(const PG8_LAS bf16x8*)(lds + PG8_SB(b, h) + boff + n * 2048 + k * 1024); } while (0)
#define PG8_MMA(ai, bj, At, Bt) do { __builtin_amdgcn_s_setprio(1); _Pragma("unroll") for (int m = 0; m < 4; ++m) _Pragma("unroll") for (int n = 0; n < 2; ++n) _Pragma("unroll") for (int k = 0; k < 2; ++k) \
        acc[ai][bj][m][n] = __builtin_amdgcn_mfma_f32_16x16x32_bf16(Bt[n][k], At[m][k], acc[ai][bj][m][n], 0, 0, 0); __builtin_amdgcn_s_setprio(0); } while (0)
#define PG8_WAIT_V(n) asm volatile("s_waitcnt vmcnt(" #n ")" ::: "memory")
#define PG8_WAIT_L(n) asm volatile("s_waitcnt lgkmcnt(" #n ")" ::: "memory")
#define PG8_BAR __builtin_amdgcn_s_barrier()
#define PG8_SCHED __builtin_amdgcn_sched_barrier(0)
    Unit cur, nxt; int ui = 0;
    if (!S.next(0, cur)) return;
    f32x4 acc[2][2][4][2];
#pragma unroll
    for (int a = 0; a < 2; ++a)
#pragma unroll
        for (int b = 0; b < 2; ++b)
#pragma unroll
            for (int m = 0; m < 4; ++m)
#pragma unroll
                for (int n = 0; n < 2; ++n) acc[a][b][m][n] = (f32x4){0.f, 0.f, 0.f, 0.f};
    bf16x8 At[4][2], B0[2][2], B1[2][2];
    const char* cA = (const char*)g.A + (size_t)cur.pm * tstep + cur.koff; const char* cB = (const char*)g.Bt + (size_t)cur.pn * tstep + cur.koff;
    S.a_ready(cur);
    if constexpr (SP2) {
        PG8_STAGE(PG8_SB(0, 0), cB, voffB); PG8_STAGE(PG8_SB(0, 1), cB + hstep, voffB); PG8_STAGE(PG8_SA(0, 0), cA, voffA); PG8_STAGE(PG8_SA(0, 1), cA + hstep, voffA);
        if (wr == 1) PG8_BAR;
        PG8_WAIT_V(2); PG8_BAR;
        PG8_STAGE(PG8_SB(1, 0), cB + kstep, voffB); PG8_STAGE(PG8_SA(1, 0), cA + kstep, voffA); PG8_STAGE(PG8_SB(1, 1), cB + hstep + kstep, voffB);
        PG8_WAIT_V(6); PG8_BAR;
    } else {
        PG8_STAGE(PG8_SB(0, 0), cB, voffB); PG8_STAGE(PG8_SA(0, 0), cA, voffA); PG8_STAGE(PG8_SB(0, 1), cB + hstep, voffB); PG8_STAGE(PG8_SA(0, 1), cA + hstep, voffA);
        if (wr == 1) PG8_BAR;
        PG8_WAIT_V(4); PG8_BAR;
        PG8_STAGE(PG8_SB(1, 0), cB + kstep, voffB); PG8_STAGE(PG8_SA(1, 0), cA + kstep, voffA); PG8_STAGE(PG8_SB(1, 1), cB + hstep + kstep, voffB);
        PG8_WAIT_V(6); PG8_BAR;
    }
    for (;;) {
        const bool has_next = S.next(ui + 1, nxt);
        const char* nA = has_next ? (const char*)g.A + (size_t)nxt.pm * tstep + nxt.koff : cA; const char* nB = has_next ? (const char*)g.Bt + (size_t)nxt.pn * tstep + nxt.koff : cB;
        const int nt = cur.nt;
        for (int t = 0; t < nt; t += 2) {
            const bool last = (t == nt - 2);
            const char* a1 = cA + (size_t)(t + 1) * kstep;
            const char* a2 = last ? nA : cA + (size_t)(t + 2) * kstep; const char* b2 = last ? nB : cB + (size_t)(t + 2) * kstep;
            const char* a3 = a2 + kstep; const char* b3 = b2 + kstep;
            if (last && has_next) S.a_ready(nxt);
            if constexpr (SP2) {
            PG8_LDB(B0, 0, 0); PG8_LDB(B1, 0, 1); PG8_SCHED; PG8_LDA(At, 0, 0); PG8_STAGE(PG8_SA(1, 1), a1 + hstep, voffA);
            PG8_WAIT_V(8); PG8_WAIT_L(0); PG8_BAR; PG8_MMA(0, 0, At, B0); PG8_MMA(0, 1, At, B1); PG8_BAR; PG8_SCHED;
            PG8_LDA(At, 0, 1); PG8_STAGE(PG8_SB(0, 0), b2, voffB); PG8_STAGE(PG8_SB(0, 1), b2 + hstep, voffB); PG8_STAGE(PG8_SA(0, 0), a2, voffA);
            PG8_WAIT_V(8); PG8_WAIT_L(0); PG8_BAR; PG8_MMA(1, 0, At, B0); PG8_MMA(1, 1, At, B1); PG8_BAR; PG8_SCHED;
            PG8_LDB(B0, 1, 0); PG8_LDB(B1, 1, 1); PG8_SCHED; PG8_LDA(At, 1, 0); PG8_STAGE(PG8_SA(0, 1), a2 + hstep, voffA);
            PG8_WAIT_V(8); PG8_WAIT_L(0); PG8_BAR; PG8_MMA(0, 0, At, B0); PG8_MMA(0, 1, At, B1); PG8_BAR; PG8_SCHED;
            PG8_LDA(At, 1, 1); PG8_STAGE(PG8_SB(1, 0), b3, voffB); PG8_STAGE(PG8_SB(1, 1), b3 + hstep, voffB); PG8_STAGE(PG8_SA(1, 0), a3, voffA);
            PG8_WAIT_V(8); PG8_WAIT_L(0); PG8_BAR; PG8_MMA(1, 0, At, B0); PG8_MMA(1, 1, At, B1); PG8_BAR; PG8_SCHED;
            } else {
            PG8_LDB(B0, 0, 0); PG8_SCHED; PG8_LDA(At, 0, 0); PG8_STAGE(PG8_SA(1, 1), a1 + hstep, voffA);
            PG8_WAIT_L(8); PG8_BAR; PG8_WAIT_L(0); PG8_MMA(0, 0, At, B0); PG8_BAR; PG8_SCHED;
            PG8_LDB(B1, 0, 1); PG8_STAGE(PG8_SB(0, 0), b2, voffB);
            PG8_BAR; PG8_WAIT_L(0); PG8_MMA(0, 1, At, B1); PG8_BAR;
            PG8_LDA(At, 0, 1); PG8_STAGE(PG8_SA(0, 0), a2, voffA);
            PG8_BAR; PG8_WAIT_L(0); PG8_MMA(1, 0, At, B0); PG8_BAR; PG8_SCHED;
            PG8_STAGE(PG8_SB(0, 1), b2 + hstep, voffB);
            PG8_WAIT_V(6); PG8_BAR; PG8_MMA(1, 1, At, B1); PG8_BAR;
            PG8_LDB(B0, 1, 0); PG8_SCHED; PG8_LDA(At, 1, 0); PG8_STAGE(PG8_SA(0, 1), a2 + hstep, voffA);
            PG8_WAIT_L(8); PG8_BAR; PG8_WAIT_L(0); PG8_MMA(0, 0, At, B0); PG8_BAR; PG8_SCHED;
            PG8_LDB(B1, 1, 1); PG8_STAGE(PG8_SB(1, 0), b3, voffB);
            PG8_BAR; PG8_WAIT_L(0); PG8_MMA(0, 1, At, B1); PG8_BAR;
            PG8_LDA(At, 1, 1); PG8_STAGE(PG8_SA(1, 0), a3, voffA);
            PG8_BAR; PG8_WAIT_L(0); PG8_MMA(1, 0, At, B0); PG8_BAR; PG8_SCHED;
            PG8_STAGE(PG8_SB(1, 1), b3 + hstep, voffB);
            PG8_WAIT_V(6); PG8_BAR; PG8_MMA(1, 1, At, B1); PG8_BAR;
            }
        }
        if constexpr (ALIGN_EPI) { if (wr == 0) PG8_BAR; }
        if constexpr (!Epi::AFTER_DRAIN) { E(acc, cur, wr, wc, fr, fq); S.done(cur); }
        if (!has_next) break;
#pragma unroll
        for (int a = 0; a < 2; ++a)
#pragma unroll
            for (int b = 0; b < 2; ++b)
#pragma unroll
                for (int m = 0; m < 4; ++m)
#pragma unroll
                    for (int n = 0; n < 2; ++n) acc[a][b][m][n] = (f32x4){0.f, 0.f, 0.f, 0.f};
        cur = nxt; cA = nA; cB = nB; ++ui;
        if constexpr (ALIGN_EPI) { if (wr == 1) PG8_BAR; }
    }
    PG8_WAIT_V(0);
    if constexpr (!ALIGN_EPI) { if (wr == 0) PG8_BAR; }
    PG8_BAR;
    if constexpr (Epi::AFTER_DRAIN) { E.fused(acc, cur, wr, wc, fr, fq, lds, wid, lane); S.done(cur); }
#undef PG8_SA
#undef PG8_SB
#undef PG8_STAGE
#undef PG8_LDA
#undef PG8_LDB
#undef PG8_MMA
#undef PG8_WAIT_V
#undef PG8_WAIT_L
#undef PG8_BAR
#undef PG8_SCHED
}
}
#define LAS __attribute__((address_space(3)))
#define DI __device__ __forceinline__
typedef unsigned short bf16;
typedef short bf16x8 __attribute__((ext_vector_type(8)));
typedef short s16x4 __attribute__((ext_vector_type(4)));
typedef float f32x4 __attribute__((ext_vector_type(4)));
typedef float f32x16 __attribute__((ext_vector_type(16)));
typedef unsigned u32x4 __attribute__((ext_vector_type(4)));
typedef unsigned u32x2 __attribute__((ext_vector_type(2)));
using pg8::pk2;
constexpr int DM = 2048, TP = 8192, NB = 32, TS = 64, MR = 10240, NL = 4, PAST = 2048, DIN = 6144, DFF = 8192, GW = 512;
constexpr float EPS = 1e-6f;
constexpr size_t MiB = 1u << 20;
constexpr size_t WS_CTL = 0, CTL_ZERO_BYTES = 1 * MiB;
constexpr size_t WS_WIN = 2 * MiB, WS_WOUT = WS_WIN + 96 * MiB, WS_WUP = WS_WOUT + 32 * MiB, WS_WDN = WS_WUP + 128 * MiB;
constexpr size_t WS_POOLW = WS_WDN + 128 * MiB;
constexpr size_t WS_XB = WS_POOLW + 1 * MiB;
constexpr size_t WS_Z = WS_XB + 40 * MiB;
constexpr size_t WS_GF = WS_Z + 120 * MiB;
constexpr size_t WS_MIX = WS_GF + 20 * MiB;
constexpr size_t WS_U = WS_MIX + 40 * MiB;
constexpr size_t WS_DS = WS_U + 160 * MiB;
constexpr size_t WS_HDEC = WS_DS + 64 * MiB;
constexpr size_t WS_SSQ = WS_HDEC + 1 * MiB;
constexpr size_t WS_SLAB = WS_SSQ + 12 * MiB;
constexpr size_t WS_LB = WS_SLAB + 64 * MiB;
constexpr size_t WS_END = WS_LB + 1 * MiB;
constexpr int CW_BAR = 4096, CW_Q = 8192, CW_DEP = 16384;
constexpr size_t O_Y = 0, O_RETP = 20971520, O_RETS = O_RETP + 262144, O_SBKP = O_RETS + 8388608, O_SBVP = O_SBKP + 16777216, O_SBKS = O_SBVP + 16777216,
                 O_SBVS = O_SBKS + 4194304, O_POOLP = O_SBVS + 4194304, O_POOLS = O_POOLP + 30720, O_HGP = O_POOLS + 983040, O_HGS = O_HGP + 262144, O_END = O_HGS + 8388608;
constexpr int LDS_CTL_OFF = 131072, LDS_BYTES = 147456;

DI float bflo(unsigned w) { return __uint_as_float(w << 16); }
DI float bfhi(unsigned w) { return __uint_as_float(w & 0xffff0000u); }
DI float fexp2(float x) { return __builtin_amdgcn_exp2f(x); }
DI float flog2(float x) { return __builtin_amdgcn_logf(x); }
DI float fexp(float x) { return __builtin_amdgcn_exp2f(x * 1.4426950408889634f); }
DI float sigmoidf_(float x) { return __builtin_amdgcn_rcpf(1.0f + fexp(-x)); }
#define MFMA32(a, b, c) __builtin_amdgcn_mfma_f32_32x32x16_bf16((a), (b), (c), 0, 0, 0)
DI int crow(int reg, int h) { return (reg & 3) + 8 * (reg >> 2) + 4 * h; }
constexpr unsigned RS = 272, TRS = 320;
DI bf16x8 ld_row(LAS const unsigned char* base, unsigned row, unsigned s, unsigned h) { return *(LAS const bf16x8*)(base + RS * row + 32u * s + 16u * h); }
DI s16x4 tr4(LAS const unsigned char* base, unsigned row0, unsigned c, unsigned lane) {
    const unsigned blk = (lane >> 4) & 1u, q = (lane & 15u) >> 2, p = lane & 3u;
    return __builtin_amdgcn_ds_read_tr16_b64_v4i16((LAS s16x4*)(base + TRS * (row0 + q) + 64u * c + 32u * blk + 8u * p));
}
DI bf16x8 tr8(LAS const unsigned char* base, unsigned rowA, unsigned rowB, unsigned c, unsigned lane) {
    const s16x4 lo = tr4(base, rowA, c, lane), hi = tr4(base, rowB, c, lane);
    return __builtin_shufflevector(lo, hi, 0, 1, 2, 3, 4, 5, 6, 7);
}
DI bf16x8 pack8(float a0, float a1, float a2, float a3, float a4, float a5, float a6, float a7) {
    u32x4 p; p.x = pk2(a0, a1); p.y = pk2(a2, a3); p.z = pk2(a4, a5); p.w = pk2(a6, a7); return __builtin_bit_cast(bf16x8, p);
}
DI f32x16 zero16() { f32x16 z; for (int i = 0; i < 16; ++i) z[i] = 0.f; return z; }
DI int wq_claim(unsigned* ctr) { return (threadIdx.x == 0) ? (int)__hip_atomic_fetch_add(ctr, 1u, __ATOMIC_RELAXED, __HIP_MEMORY_SCOPE_AGENT) : 0; }
DI int wq_next(unsigned* ctr, volatile LAS int* slot, int& pre, int& par) {
    if (threadIdx.x == 0) slot[par] = pre;
    __syncthreads();
    const int it = slot[par];
    par ^= 1;
    pre = wq_claim(ctr);
    return it;
}
DI void st_wt(float* p, float v) { __hip_atomic_store((unsigned*)p, __float_as_uint(v), __ATOMIC_RELAXED, __HIP_MEMORY_SCOPE_AGENT); }
DI float ld_wt(const float* p) { return __uint_as_float(__hip_atomic_load((const unsigned*)p, __ATOMIC_RELAXED, __HIP_MEMORY_SCOPE_AGENT)); }
DI void st_wt32(unsigned* p, unsigned v) { __hip_atomic_store(p, v, __ATOMIC_RELAXED, __HIP_MEMORY_SCOPE_AGENT); }
DI unsigned ld_wt32(const unsigned* p) { return __hip_atomic_load(p, __ATOMIC_RELAXED, __HIP_MEMORY_SCOPE_AGENT); }
DI unsigned long long ld_wt64(const unsigned long long* p) { return __hip_atomic_load(p, __ATOMIC_RELAXED, __HIP_MEMORY_SCOPE_AGENT); }
DI void dep_publish(unsigned* ctr) {
    asm volatile("s_waitcnt vmcnt(0)" ::: "memory");
    __syncthreads();
    if (threadIdx.x == 0) __hip_atomic_fetch_add(ctr, 1u, __ATOMIC_RELAXED, __HIP_MEMORY_SCOPE_AGENT);
}
DI void dep_wait(unsigned* ctr, const unsigned need, unsigned* tmo) {
    if (threadIdx.x == 0) {
        unsigned sp = 0;
        while (__hip_atomic_load(ctr, __ATOMIC_RELAXED, __HIP_MEMORY_SCOPE_AGENT) < need) {
            __builtin_amdgcn_s_sleep(2);
            if ((++sp & 1023u) == 0u) { if (__hip_atomic_load(tmo, __ATOMIC_RELAXED, __HIP_MEMORY_SCOPE_AGENT) != 0u) break; if (sp > (1u << 22)) { __hip_atomic_fetch_add(tmo, 1u, __ATOMIC_RELAXED, __HIP_MEMORY_SCOPE_AGENT); break; } }
        }
        __builtin_amdgcn_fence(__ATOMIC_ACQUIRE, "agent");
        asm volatile("s_waitcnt vmcnt(0)" ::: "memory");
    }
    __syncthreads();
}
DI void dep_wait_sc1(unsigned* ctr, const unsigned need, unsigned* tmo) {
    if (threadIdx.x == 0) {
        unsigned sp = 0;
        while (__hip_atomic_load(ctr, __ATOMIC_RELAXED, __HIP_MEMORY_SCOPE_AGENT) < need) {
            __builtin_amdgcn_s_sleep(2);
            if ((++sp & 1023u) == 0u) { if (__hip_atomic_load(tmo, __ATOMIC_RELAXED, __HIP_MEMORY_SCOPE_AGENT) != 0u) break; if (sp > (1u << 22)) { __hip_atomic_fetch_add(tmo, 1u, __ATOMIC_RELAXED, __HIP_MEMORY_SCOPE_AGENT); break; } }
        }
    }
    __builtin_amdgcn_fence(__ATOMIC_ACQUIRE, "wavefront");
    __syncthreads();
}
#define XB_TMO      128
#define XB_XCNT(j)  (256  + 64 * (j))
#define XB_XSUB(j)  (1280 + 64 * (j))
#define XB_XGEN(j)  (2304 + 64 * (j))
#define XB_TOP      3328
#define XB_TOPGEN   3392
#define XCD_BAR_WORDS 3456
#define XB_SPIN_CAP (1u << 18)

__device__ __forceinline__ unsigned xb_ld(unsigned* p)              { return __hip_atomic_load(p, __ATOMIC_RELAXED, __HIP_MEMORY_SCOPE_AGENT); }
__device__ __forceinline__ unsigned xb_add(unsigned* p, unsigned v) { return __hip_atomic_fetch_add(p, v, __ATOMIC_RELAXED, __HIP_MEMORY_SCOPE_AGENT); }
__device__ __forceinline__ unsigned xb_xcc_id() { return (unsigned)__builtin_amdgcn_s_getreg((3 << 11) | 20) & 0xFu; }
#define XB_SPIN(cond, bar) do { unsigned _sp = 0; while (cond) { __builtin_amdgcn_s_sleep(1); \
    if ((++_sp & 255u) == 0u) { if (xb_ld(&(bar)[XB_TMO])) break; if (_sp > XB_SPIN_CAP) { atomicAdd(&(bar)[XB_TMO], 1u); break; } } } } while (0)

struct XcdBarrier {
    unsigned* bar; unsigned x;
    volatile LAS unsigned* st;
};

__device__ __forceinline__ XcdBarrier xcd_barrier_post(unsigned* bar, volatile LAS unsigned* st) {
    XcdBarrier b; b.bar = bar; b.x = xb_xcc_id(); b.st = st;
    if (threadIdx.x == 0) (void)xb_add(&bar[XB_XCNT(b.x)], 1u);
    return b;
}
__device__ __forceinline__ void xcd_barrier_complete(unsigned* bar, unsigned x, unsigned& nloc, unsigned& nx) {
    const unsigned G = gridDim.x * gridDim.y * gridDim.z;
    unsigned sum, cnt, mine, sp = 0u;
    for (;;) {
        sum = 0u; cnt = 0u; mine = 0u;
#pragma unroll
        for (unsigned j = 0; j < 16; ++j) { const unsigned c = xb_ld(&bar[XB_XCNT(j)]); sum += c; cnt += (c > 0u) ? 1u : 0u; mine = (j == x) ? c : mine; }
        if (sum == G) break;
        __builtin_amdgcn_s_sleep(1);
        if ((++sp & 255u) == 0u) { if (xb_ld(&bar[XB_TMO])) break; if (sp > XB_SPIN_CAP) { atomicAdd(&bar[XB_TMO], 1u); break; } }
    }
    nloc = mine > 0u ? mine : 1u; nx = cnt > 0u ? cnt : 1u;
}

__device__ __forceinline__ void xcd_barrier(const XcdBarrier& b) {
    asm volatile("s_waitcnt vmcnt(0)" ::: "memory");
    __syncthreads();
    if (threadIdx.x == 0) {
        unsigned* bar = b.bar;
        __builtin_amdgcn_s_waitcnt(0);
        unsigned nloc = b.st[0], nx = b.st[1];
        if (nloc == 0u) { xcd_barrier_complete(bar, b.x, nloc, nx); b.st[0] = nloc; b.st[1] = nx; }
        const unsigned old = xb_add(&bar[XB_XSUB(b.x)], 1u);
        const unsigned gen = old / nloc;
        if (old + 1u == (gen + 1u) * nloc) {
            __builtin_amdgcn_fence(__ATOMIC_RELEASE, "agent");
            asm volatile("s_waitcnt vmcnt(0)" ::: "memory");
            const unsigned og = xb_add(&bar[XB_TOP], 1u);
            const unsigned tg = og / nx;
            if (og + 1u == (tg + 1u) * nx) xb_add(&bar[XB_TOPGEN], 1u);
            else XB_SPIN(xb_ld(&bar[XB_TOPGEN]) == tg, bar);
            __builtin_amdgcn_fence(__ATOMIC_ACQUIRE, "agent");
            xb_add(&bar[XB_XGEN(b.x)], 1u);
            asm volatile("s_waitcnt vmcnt(0)" ::: "memory");
        } else {
            XB_SPIN(xb_ld(&bar[XB_XGEN(b.x)]) == gen, bar);
            __builtin_amdgcn_fence(__ATOMIC_ACQUIRE, "agent");
            asm volatile("s_waitcnt vmcnt(0)" ::: "memory");
        }
    }
    __syncthreads();
}
struct TrItem { const float* src; bf16* dst; int N, K; f32x4 gq[4]; float cs; };
DI void tr_setup(TrItem& t, const float* W, const int K, const int N, bf16* WT, const float* kgain, const int cs_lo1, const int cs_hi1, const float cs1, const int cs_lo2, const int cs_hi2, const float cs2,
                 const int item, const int lane) {
    const int nblk = N / 64, kb = item / nblk, nb = item % nblk, k0 = 64 * kb, n0 = 64 * nb;
    const int n4 = lane & 15, kq = lane >> 4, ncol = n0 + 4 * n4;
    const float cs = (ncol >= cs_lo1 && ncol < cs_hi1) ? cs1 : ((ncol >= cs_lo2 && ncol < cs_hi2) ? cs2 : 1.0f);
    t.src = W + (size_t)(k0 + 8 * kq) * N + ncol; t.dst = WT + (size_t)ncol * K + k0 + 8 * kq; t.N = N; t.K = K;
    t.cs = cs;
#pragma unroll
    for (int q = 0; q < 4; ++q) t.gq[q] = *(const f32x4*)(kgain + k0 + 8 * kq + 4 * (q & 1) + 32 * (q >> 1));
}
DI void tr_load(const TrItem& t, f32x4 (&v)[16]) {
#pragma unroll
    for (int i = 0; i < 16; ++i) v[i] = __builtin_nontemporal_load((const f32x4*)(t.src + (size_t)((i & 7) + 32 * (i >> 3)) * t.N));
}
DI void tr_store(const TrItem& t, const f32x4 (&v)[16]) {
    float gk[16];
#pragma unroll
    for (int i = 0; i < 16; ++i) gk[i] = t.gq[i >> 2][i & 3] * t.cs;
#pragma unroll
    for (int e = 0; e < 4; ++e) {
        bf16* dst = t.dst + (size_t)e * t.K;
        *(bf16x8*)(dst) = pack8(v[0][e] * gk[0], v[1][e] * gk[1], v[2][e] * gk[2], v[3][e] * gk[3], v[4][e] * gk[4], v[5][e] * gk[5], v[6][e] * gk[6], v[7][e] * gk[7]);
        *(bf16x8*)(dst + 32) = pack8(v[8][e] * gk[8], v[9][e] * gk[9], v[10][e] * gk[10], v[11][e] * gk[11], v[12][e] * gk[12], v[13][e] * gk[13], v[14][e] * gk[14], v[15][e] * gk[15]);
    }
}
constexpr int CV_IN = (DM / 64) * (DIN / 64), CV_OUT = (DM / 64) * (DM / 64), CV_UP = (DM / 64) * (DFF / 64), CV_DN = (DFF / 64) * (DM / 64);
DI void conv_setup(TrItem& t, const float* w_in, const float* w_out, const float* w_up, const float* w_down, const float* norm1_g, const float* norm2_g, const float* ones, bf16* WinT, bf16* WoutT, bf16* WupT, bf16* WdnT,
                   const int l, const int rr, const int lane) {
    const int which = (rr >= CV_IN) + (rr >= CV_IN + CV_OUT) + (rr >= CV_IN + CV_OUT + CV_UP);
    const int item = rr - (which >= 1 ? CV_IN : 0) - (which >= 2 ? CV_OUT : 0) - (which >= 3 ? CV_UP : 0);
    const float* W = which == 0 ? w_in + (size_t)l * DM * DIN : which == 1 ? w_out + (size_t)l * DM * DM : which == 2 ? w_up + (size_t)l * DM * DFF : w_down + (size_t)l * DFF * DM;
    bf16* WT = which == 0 ? WinT + (size_t)l * DIN * DM : which == 1 ? WoutT + (size_t)l * DM * DM : which == 2 ? WupT + (size_t)l * DFF * DM : WdnT + (size_t)l * DM * DFF;
    const int K = which == 3 ? DFF : DM, N = which == 0 ? DIN : which == 2 ? DFF : DM;
    const float* kg = which == 0 ? norm1_g + l * DM : which == 2 ? norm2_g + l * DM : ones;
    const int lo1 = which == 0 ? 512 : 0, hi1 = which == 0 ? 1024 : 0, lo2 = which == 0 ? 2048 : 0, hi2 = which == 0 ? 2560 : 0;
    tr_setup(t, W, K, N, WT, kg, lo1, hi1, 0.08838834764831845f, lo2, hi2, 0.08838834764831845f * 1.4426950408889634f, item, lane);
}
DI void conv_wave_pair(const float* w_in, const float* w_out, const float* w_up, const float* w_down, const float* norm1_g, const float* norm2_g, const float* ones, bf16* WinT, bf16* WoutT, bf16* WupT, bf16* WdnT,
                       const int l0, const int r0, const int l1, const int r1, const int lane) {
    TrItem t0, t1; f32x4 v0[16], v1[16];
    conv_setup(t0, w_in, w_out, w_up, w_down, norm1_g, norm2_g, ones, WinT, WoutT, WupT, WdnT, l0, r0, lane); tr_load(t0, v0);
    conv_setup(t1, w_in, w_out, w_up, w_down, norm1_g, norm2_g, ones, WinT, WoutT, WupT, WdnT, l1, r1, lane); tr_load(t1, v1);
    tr_store(t0, v0); tr_store(t1, v1);
}
struct ConvCtx { const float* w_in; const float* w_out; const float* w_up; const float* w_down; const float* norm1_g; const float* norm2_g; const float* ones; bf16* WinT; bf16* WoutT; bf16* WupT; bf16* WdnT; };
DI bool conv_list_setup(TrItem& t, const ConvCtx& c, const int l, const int wi_in, const int lane) {
    const bool on = (wi_in >= 0) && ((wi_in < CV_OUT + CV_UP + CV_DN) || (l + 1 < NL));
    const int wi = on ? wi_in : 0;
    const bool nextl = wi >= CV_OUT + CV_UP + CV_DN;
    conv_setup(t, c.w_in, c.w_out, c.w_up, c.w_down, c.norm1_g, c.norm2_g, c.ones, c.WinT, c.WoutT, c.WupT, c.WdnT, nextl ? l + 1 : l, nextl ? wi - (CV_OUT + CV_UP + CV_DN) : CV_IN + wi, lane);
    return on;
}
struct SbArgs {
    const bf16* zq; const bf16* zk; const bf16* zv;
    const float* kc; const float* vc;
    int nf32, t_hi, qpos0, nqw;
    bf16* mixo;
    float* ok; int ovd, own_lo;
};
typedef float f32x2 __attribute__((ext_vector_type(2)));
DI void sb_sub(LAS const unsigned char* Kb, LAS const unsigned char* Vb, const bf16x8 (&qf)[8], f32x16 (&O)[4], float& R, const int kt, const int kp_base, const int qp,
               const bool needmask, const int r, const int h, const int lane) {
    f32x16 X = zero16();
#pragma unroll
    for (int s = 0; s < 8; ++s) X = MFMA32(ld_row(Kb, 32 * kt + r, s, h), qf[s], X);
    f32x2 E[8], F[8];
#pragma unroll
    for (int p = 0; p < 2; ++p)
#pragma unroll
        for (int jj = 0; jj < 4; ++jj) {
            f32x2 u2 = {X[8 * p + jj], X[8 * p + 4 + jj]};
            u2 = __builtin_elementwise_min(u2, (f32x2){64.f, 64.f});
            f32x2 e2; e2.x = fexp2(u2.x); e2.y = fexp2(u2.y);
            const f32x2 d2 = e2 + 1.0f;
            f32x2 f2; f2.x = __builtin_amdgcn_rcpf(d2.x); f2.y = __builtin_amdgcn_rcpf(d2.y);
            E[4 * p + jj] = e2; F[4 * p + jj] = f2;
        }
    if (needmask) {
#pragma unroll
        for (int p = 0; p < 2; ++p)
#pragma unroll
            for (int jj = 0; jj < 4; ++jj) {
                const int kpa = kp_base + 4 * h + jj + 8 * (2 * p), kpb = kpa + 8;
                const bool va = kpa < qp, vb = kpb < qp;
                E[4 * p + jj].x = va ? E[4 * p + jj].x : 0.f; F[4 * p + jj].x = va ? F[4 * p + jj].x : 1.f;
                E[4 * p + jj].y = vb ? E[4 * p + jj].y : 0.f; F[4 * p + jj].y = vb ? F[4 * p + jj].y : 1.f;
            }
    }
    float gp[4], pp[4], pt[4], T[4];
#pragma unroll
    for (int p = 0; p < 2; ++p) { const f32x2 g2 = (F[4 * p] * F[4 * p + 1]) * (F[4 * p + 2] * F[4 * p + 3]); gp[2 * p] = g2.x; gp[2 * p + 1] = g2.y; }
#pragma unroll
    for (int g = 0; g < 4; ++g) { const unsigned x = __float_as_uint(gp[g]); const auto sw = __builtin_amdgcn_permlane32_swap(x, x, false, false);
        const float a0 = __uint_as_float(sw[0]), a1 = __uint_as_float(sw[1]);
        pp[g] = a0 * a1; pt[g] = (h == 0) ? a1 : 1.0f; }
    T[3] = 1.0f; T[2] = pp[3]; T[1] = T[2] * pp[2]; T[0] = T[1] * pp[1];
    float P[16];
#pragma unroll
    for (int p = 0; p < 2; ++p) {
        f32x2 c2 = {R * T[2 * p] * pt[2 * p], R * T[2 * p + 1] * pt[2 * p + 1]};
#pragma unroll
        for (int jj = 3; jj >= 0; --jj) { c2 = c2 * F[4 * p + jj]; const f32x2 a2 = E[4 * p + jj] * c2; P[8 * p + jj] = a2.x; P[8 * p + 4 + jj] = a2.y; }
    }
    R = R * (T[0] * pp[0]);
    const bf16x8 pa0 = pack8(P[0], P[1], P[2], P[3], P[4], P[5], P[6], P[7]), pa1 = pack8(P[8], P[9], P[10], P[11], P[12], P[13], P[14], P[15]);
#pragma unroll
    for (int ei = 0; ei < 4; ++ei) {
        const bf16x8 vb0 = tr8(Vb, 32 * kt + 4 * h, 32 * kt + 8 + 4 * h, ei, lane);
        O[ei] = MFMA32(pa0, vb0, O[ei]);
        const bf16x8 vb1 = tr8(Vb, 32 * kt + 16 + 4 * h, 32 * kt + 24 + 4 * h, ei, lane);
        O[ei] = MFMA32(pa1, vb1, O[ei]);
    }
}
constexpr int SB_V0 = 64 * 272, SB_BUF = 64 * 272 + 64 * 320;
constexpr int SB_CVN = 4;
DI void sb_item(LAS unsigned char* lds, const SbArgs& a, const ConvCtx& cvx, const int cv_l, const int cv_base, const int tid_in) {
    int tid = tid_in; asm volatile("" : "+v"(tid));
    const int lane = tid & 63, w = __builtin_amdgcn_readfirstlane(tid >> 6), r = lane & 31, h = lane >> 5;
    const bool active = w < a.nqw;
    u32x4 st[4];
#define SB_LOAD(j) do { if ((j) < a.nf32) { \
        _Pragma("unroll") for (int i_ = 0; i_ < 2; ++i_) { const int n_ = tid + 512 * i_, row_ = n_ >> 5, c4_ = n_ & 31; const size_t o_ = (size_t)(32 * (j) + row_) * 512 + 4 * c4_; \
            st[i_] = *(const u32x4*)(a.kc + o_); st[2 + i_] = *(const u32x4*)(a.vc + o_); } \
    } else { const int jj_ = (j) - a.nf32; \
        _Pragma("unroll") for (int i_ = 0; i_ < 2; ++i_) { const int n_ = tid + 512 * i_, row_ = n_ >> 4, ch_ = n_ & 15; const size_t o_ = (size_t)(64 * jj_ + row_) * 6144 + 8 * ch_; \
            st[i_] = *(const u32x4*)(a.zk + o_); st[2 + i_] = *(const u32x4*)(a.zv + o_); } } } while (0)
#define SB_WRITE(j, Kd, Vd) do { if ((j) < a.nf32) { \
        _Pragma("unroll") for (int i_ = 0; i_ < 2; ++i_) { const int n_ = tid + 512 * i_, row_ = n_ >> 5, c4_ = n_ & 31; const unsigned ok_ = RS * row_ + 8u * c4_, ov_ = TRS * row_ + 8u * c4_; \
            u32x2 kk_, vv_; kk_.x = pk2(__uint_as_float(st[i_].x), __uint_as_float(st[i_].y)); kk_.y = pk2(__uint_as_float(st[i_].z), __uint_as_float(st[i_].w)); \
            vv_.x = pk2(__uint_as_float(st[2 + i_].x), __uint_as_float(st[2 + i_].y)); vv_.y = pk2(__uint_as_float(st[2 + i_].z), __uint_as_float(st[2 + i_].w)); \
            *(LAS u32x2*)((Kd) + ok_) = kk_; *(LAS u32x2*)((Vd) + ov_) = vv_; } \
    } else { const bool own_ = (j) >= a.own_lo; const int jw_ = (j) - a.nf32; \
        _Pragma("unroll") for (int i_ = 0; i_ < 2; ++i_) { const int n_ = tid + 512 * i_, row_ = n_ >> 4, ch_ = n_ & 15; \
            *(LAS u32x4*)((Kd) + RS * row_ + 16u * ch_) = st[i_]; *(LAS u32x4*)((Vd) + TRS * row_ + 16u * ch_) = st[2 + i_]; \
            if (own_) { const unsigned oo_ = (unsigned)((64 * jw_ + row_) * 512 + 8 * ch_) * 4u; const u32x4 k_ = st[i_], v_ = st[2 + i_]; char* pk_ = (char*)a.ok; char* pv_ = (char*)(a.ok + a.ovd); \
                *(f32x4*)(pk_ + oo_) = (f32x4){bflo(k_.x), bfhi(k_.x), bflo(k_.y), bfhi(k_.y)}; *(f32x4*)(pk_ + oo_ + 16u) = (f32x4){bflo(k_.z), bfhi(k_.z), bflo(k_.w), bfhi(k_.w)}; \
                *(f32x4*)(pv_ + oo_) = (f32x4){bflo(v_.x), bfhi(v_.x), bflo(v_.y), bfhi(v_.y)}; *(f32x4*)(pv_ + oo_ + 16u) = (f32x4){bflo(v_.z), bfhi(v_.z), bflo(v_.w), bfhi(v_.w)}; } } } } while (0)
#define SB_WALK(BODY, FLAG) do { int cur = 0; \
    for (int j = a.t_hi; j >= 0; --j) { \
        LAS unsigned char* Kb = lds + cur * SB_BUF; LAS unsigned char* Vb = Kb + SB_V0; \
        if (j > 0) SB_LOAD(j - 1); \
        BODY \
        if (j > 0) SB_WRITE(j - 1, lds + (cur ^ 1) * SB_BUF, lds + (cur ^ 1) * SB_BUF + SB_V0); \
        if (lane == 0) dflag[8 * cur + w] = (FLAG) ? 1 : 0; \
        __syncthreads(); \
        {   int alld = 1; \
            _Pragma("unroll") for (int i = 0; i < 8; ++i) alld &= dflag[8 * cur + i]; \
            if (alld) break; } \
        cur ^= 1; \
    } } while (0)
    volatile LAS int* dflag = (volatile LAS int*)(lds + 2 * SB_BUF);
    if (active) {
        bf16x8 qf[8];
        {   const bf16* qp_ = a.zq + (size_t)(32 * w + r) * 6144 + 8 * h;
#pragma unroll
            for (int s = 0; s < 8; ++s) qf[s] = *(const bf16x8*)(qp_ + 16 * s); }
        f32x16 O[4]; O[0] = zero16(); O[1] = zero16(); O[2] = zero16(); O[3] = zero16();
        float R = 1.0f;
        const int qmin = a.qpos0 + 32 * w, qmax = qmin + 31, qp = qmin + r;
        SB_LOAD(a.t_hi); SB_WRITE(a.t_hi, lds, lds + SB_V0);
        __syncthreads();
        SB_WALK({
            const bool f32t = j < a.nf32;
            const int kp0 = f32t ? 32 * j : 32 * a.nf32 + 64 * (j - a.nf32);
            const int nk = f32t ? 32 : 64;
            if (kp0 < qmax) {
                const bool needmask = (kp0 + nk - 1 >= qmin);
                if (!f32t) sb_sub(Kb, Vb, qf, O, R, 1, kp0 + 32, qp, needmask, r, h, lane);
                sb_sub(Kb, Vb, qf, O, R, 0, kp0, qp, needmask, r, h, lane);
            } }, (__ballot(R != 0.0f) == 0ull));
        LAS unsigned char* ob = lds + w * 8192;
#pragma unroll
        for (int ei = 0; ei < 4; ++ei)
#pragma unroll
            for (int i = 0; i < 16; ++i) *(LAS unsigned short*)(ob + crow(i, h) * 256 + (32 * ei + r) * 2) = (unsigned short)(pk2(O[ei][i], 0.f) & 0xffffu);
#pragma unroll
        for (int i = 0; i < 8; ++i) { const int n = lane + 64 * i, row = n >> 4, ch = n & 15;
            const u32x4 v = *(LAS const u32x4*)(ob + row * 256 + ch * 16);
            *(u32x4*)(a.mixo + (size_t)(32 * w + row) * 2048 + 8 * ch) = v; }
    } else {
        TrItem tA; f32x4 vA[16]; bool onA = false;
        const int cvw = cv_base + (w - a.nqw) * SB_CVN;
        int ci = (cv_base >= 0) ? 0 : SB_CVN, cs = ci;
        for (int i = 0; i < 16; ++i) vA[i] = (f32x4){0.f, 0.f, 0.f, 0.f};
        tA.src = nullptr; tA.dst = nullptr; tA.N = 0; tA.K = 0; tA.cs = 0.f;
        for (int q = 0; q < 4; ++q) tA.gq[q] = (f32x4){0.f, 0.f, 0.f, 0.f};
        SB_LOAD(a.t_hi); SB_WRITE(a.t_hi, lds, lds + SB_V0);
        __syncthreads();
        SB_WALK({
            if (cs < ci) { if (onA) tr_store(tA, vA); ++cs; }
            if (ci < SB_CVN) { onA = conv_list_setup(tA, cvx, cv_l, cvw + ci, lane); tr_load(tA, vA); ++ci; } }, true);
        while (cs < SB_CVN) {
            if (cs == ci) { onA = conv_list_setup(tA, cvx, cv_l, cvw + ci, lane); tr_load(tA, vA); ++ci; }
            if (onA) tr_store(tA, vA);
            ++cs; }
    }
#undef SB_WALK
#undef SB_LOAD
#undef SB_WRITE
}
constexpr int LA_QT = 0, LA_QI = 17408, LA_KT = 34816, LA_KS = 52224, LA_VV = 72704, LA_G = 93184;
struct LaArgs {
    const bf16* z;
    int h, pos0, mode, prompt;
    const float* Sprev;
    const bf16* SpT;
    bf16* dSout;
    float* Sout;
    float* hdec;
    const float* ng;
    const float* lbsrc;
    int layer;
    bf16* mixo;
    unsigned* pub_prev;
    unsigned* dep_done; unsigned* dep_need; unsigned* tmo;
    int cv_wi;
};
template <int MIXER, int MODE>
DI void la_item(LAS unsigned char* lds, const LaArgs& a, const ConvCtx& cvx, const int tid_in) {
    int tid = tid_in; asm volatile("" : "+v"(tid));
    const int lane = tid & 63, w = __builtin_amdgcn_readfirstlane(tid >> 6), r = lane & 31, h = lane >> 5;
    LAS unsigned char* QT = lds + LA_QT; LAS unsigned char* QI = lds + LA_QI; LAS unsigned char* KT = lds + LA_KT; LAS unsigned char* KS = lds + LA_KS; LAS unsigned char* VV = lds + LA_VV;
    LAS float* G = (LAS float*)(lds + LA_G);
    bool pubdone = false;
    if (MODE == 2 && a.dep_need) { if (a.pub_prev) { dep_publish(a.pub_prev); pubdone = true; } dep_wait_sc1(a.dep_need, 16u, a.tmo); }
    float sv[8][8]; unsigned long long svq[8][2]; u32x4 gw0 = {0u, 0u, 0u, 0u}, gw1 = {0u, 0u, 0u, 0u}; f32x4 ngv[4];
    if (MODE == 2) {
        const unsigned long long* sp0 = (const unsigned long long*)(a.SpT + (32 * (w & 3) + r) * 128 + 8 * h);
#pragma unroll
        for (int s = 0; s < 8; ++s) { svq[s][0] = ld_wt64(sp0 + 4 * s); svq[s][1] = ld_wt64(sp0 + 4 * s + 1); }
    }
    if (MODE & 2) {
        const bf16* gz = a.z + (size_t)(tid >> 3) * 6144 + (MIXER == 0 ? 3 * 512 : 11 * 512) + a.h * 128 + 16 * (tid & 7);
        gw0 = *(const u32x4*)(gz); gw1 = *(const u32x4*)(gz + 8);
#pragma unroll
        for (int q4 = 0; q4 < 4; ++q4) ngv[q4] = *(const f32x4*)(a.ng + 16 * (tid & 7) + 4 * q4);
    }
    float decay_s = 1.f;
    if (MIXER == 0) {
        const float lg = flog2(1.0f - fexp2(-5.0f - (float)a.h));
        decay_s = fexp2(64.0f * lg);
        const int m = tid >> 3, j0 = 8 * (tid & 7);
        const bf16* zr = a.z + (size_t)m * 6144 + a.h * 128;
        const u32x4 q1 = *(const u32x4*)(zr + j0), q2 = *(const u32x4*)(zr + 64 + j0), k1 = *(const u32x4*)(zr + 512 + j0), k2 = *(const u32x4*)(zr + 512 + 64 + j0);
        const u32x4 v0 = *(const u32x4*)(zr + 1024 + 2 * j0), v1 = *(const u32x4*)(zr + 1024 + 2 * j0 + 8);
        const float posf = (float)(a.pos0 + m);
        const float sqt = fexp2((float)(m - 32) * lg), sqi = fexp2((float)(m + 1) * lg), skt = fexp2((float)(32 - m) * lg), sks = fexp2((float)(63 - m) * lg);
        float qa[8], qb[8], ka[8], kb[8];
#pragma unroll
        for (int jj = 0; jj < 8; ++jj) {
            const unsigned wq1 = q1[jj >> 1], wq2 = q2[jj >> 1], wk1 = k1[jj >> 1], wk2 = k2[jj >> 1];
            const float x1 = (jj & 1) ? bfhi(wq1) : bflo(wq1), x2 = (jj & 1) ? bfhi(wq2) : bflo(wq2), y1 = (jj & 1) ? bfhi(wk1) : bflo(wk1), y2 = (jj & 1) ? bfhi(wk2) : bflo(wk2);
            const float inv = fexp2(-(float)(j0 + jj) * (13.287712379549449f / 64.0f));
            const float ang = posf * inv;
            const float fr = __builtin_amdgcn_fractf(ang * 0.15915494309189535f);
            const float sn = __builtin_amdgcn_sinf(fr), cs = __builtin_amdgcn_cosf(fr);
            qa[jj] = x1 * cs - x2 * sn; qb[jj] = x1 * sn + x2 * cs; ka[jj] = y1 * cs - y2 * sn; kb[jj] = y1 * sn + y2 * cs;
        }
        const unsigned c1 = (unsigned)(tid & 7), c2 = c1 + 8u;
#define LA_ST(T, ST, ch, AR, sc) do { u32x4 p_; p_[0] = pk2(AR[0] * (sc), AR[1] * (sc)); p_[1] = pk2(AR[2] * (sc), AR[3] * (sc)); p_[2] = pk2(AR[4] * (sc), AR[5] * (sc)); p_[3] = pk2(AR[6] * (sc), AR[7] * (sc)); \
            *(LAS u32x4*)((T) + (ST) * m + 16u * (ch)) = p_; } while (0)
        if (MODE & 2) { LA_ST(QT, RS, c1, qa, sqt); LA_ST(QT, RS, c2, qb, sqt); LA_ST(QI, RS, c1, qa, sqi); LA_ST(QI, RS, c2, qb, sqi); LA_ST(KT, RS, c1, ka, skt); LA_ST(KT, RS, c2, kb, skt); }
        if (MODE & 1) { LA_ST(KS, TRS, c1, ka, sks); LA_ST(KS, TRS, c2, kb, sks); }
        *(LAS u32x4*)(VV + TRS * m + 32u * c1) = v0; *(LAS u32x4*)(VV + TRS * m + 32u * c1 + 16u) = v1;
    } else {
        const int m = tid >> 3, d0 = 16 * (tid & 7);
        const bf16* zr = a.z + (size_t)m * 6144 + a.h * 128 + d0;
        const u32x4 fw0 = *(const u32x4*)(zr + 9 * 512), fw1 = *(const u32x4*)(zr + 9 * 512 + 8);
        float kk[16];
#pragma unroll
        for (int q4 = 0; q4 < 4; ++q4) {
            f32x4 lfv;
#pragma unroll
            for (int jj = 0; jj < 4; ++jj) {
                const int c = a.h * 128 + d0 + 4 * q4 + jj;
                const float lb = a.lbsrc[c];
                const unsigned wf = (q4 < 2) ? fw0[(4 * q4 + jj) >> 1] : fw1[(4 * q4 + jj - 8) >> 1];
                const float x = (jj & 1) ? bfhi(wf) : bflo(wf);
                const float ex = fexp(-fmaxf(x, -80.0f)), sg = __builtin_amdgcn_rcpf(1.0f + ex);
                const float f = lb + (1.0f - lb) * sg;
                lfv[jj] = flog2(f) * 0.6931471805599453f;
                kk[4 * q4 + jj] = (1.0f - lb) * (ex * sg);
            }
            *(LAS f32x4*)(G + m * 128 + d0 + 4 * q4) = lfv;
        }
        __syncthreads();
        {
            const int d = tid & 127, seg = tid >> 7; float v[16]; float run = 0.f;
#pragma unroll
            for (int i = 0; i < 16; ++i) { run += G[(16 * seg + i) * 128 + d]; v[i] = run; }
#pragma unroll
            for (int i = 0; i < 16; ++i) G[(16 * seg + i) * 128 + d] = v[i];
            __syncthreads();
            float pre = 0.f;
#pragma unroll
            for (int s2 = 0; s2 < 3; ++s2) { const float t = G[(16 * s2 + 15) * 128 + d]; pre += (s2 < seg) ? t : 0.f; }
            __syncthreads();
            if (seg > 0) {
#pragma unroll
                for (int i = 0; i < 16; ++i) G[(16 * seg + i) * 128 + d] = v[i] + pre;
            }
        }
        __syncthreads();
        const u32x4 qw0 = *(const u32x4*)(zr + 8 * 512), qw1 = *(const u32x4*)(zr + 8 * 512 + 8);
        const u32x4 vw0 = *(const u32x4*)(zr + 10 * 512), vw1 = *(const u32x4*)(zr + 10 * 512 + 8);
        float qt[16], qi[16], kt[16], ks[16];
#pragma unroll
        for (int jj = 0; jj < 16; ++jj) {
            const unsigned wq = (jj < 8) ? qw0[jj >> 1] : qw1[(jj - 8) >> 1];
            const float qraw = (jj & 1) ? bfhi(wq) : bflo(wq);
            const float qs = qraw * sigmoidf_(qraw);
            const float g = G[m * 128 + d0 + jj], gm = G[31 * 128 + d0 + jj], gl = G[63 * 128 + d0 + jj];
            if (MODE & 2) { qt[jj] = qs * fexp(g - gm); qi[jj] = qs * fexp(g); kt[jj] = kk[jj] * fexp(gm - g); } else { qt[jj] = 0.f; qi[jj] = 0.f; kt[jj] = 0.f; }
            ks[jj] = (MODE & 1) ? kk[jj] * fexp(gl - g) : 0.f;
        }
        const unsigned c1 = 2u * (unsigned)(tid & 7);
#define LA_ST2(T, ST, AR) do { u32x4 p_; p_[0] = pk2(AR[0], AR[1]); p_[1] = pk2(AR[2], AR[3]); p_[2] = pk2(AR[4], AR[5]); p_[3] = pk2(AR[6], AR[7]); *(LAS u32x4*)((T) + (ST) * m + 16u * c1) = p_; \
            u32x4 r_; r_[0] = pk2(AR[8], AR[9]); r_[1] = pk2(AR[10], AR[11]); r_[2] = pk2(AR[12], AR[13]); r_[3] = pk2(AR[14], AR[15]); *(LAS u32x4*)((T) + (ST) * m + 16u * c1 + 16u) = r_; } while (0)
        if (MODE & 2) { LA_ST2(QT, RS, qt); LA_ST2(QI, RS, qi); LA_ST2(KT, RS, kt); }
        if (MODE & 1) { LA_ST2(KS, TRS, ks); }
        *(LAS u32x4*)(VV + TRS * m + 16u * c1) = vw0; *(LAS u32x4*)(VV + TRS * m + 16u * c1 + 16u) = vw1;
        if ((MODE == 1) && tid < 128) st_wt(a.hdec + tid, fexp(G[63 * 128 + tid]));
    }
    const bool qpub = a.pub_prev && !pubdone;
    if (qpub) asm volatile("s_waitcnt vmcnt(0)" ::: "memory");
    TrItem cvt; f32x4 cvv[16];
    const bool cvreq = (MODE != 3) && a.cv_wi >= 0;
    const bool cvon = conv_list_setup(cvt, cvx, a.layer, cvreq ? a.cv_wi + w : -1, lane);
    if (cvreq) tr_load(cvt, cvv); else { for (int i = 0; i < 16; ++i) cvv[i] = (f32x4){0.f, 0.f, 0.f, 0.f}; }
    __syncthreads();
    if (qpub && tid == 0) __hip_atomic_fetch_add(a.pub_prev, 1u, __ATOMIC_RELAXED, __HIP_MEMORY_SCOPE_AGENT);
    float upd[2][16];
    if (MODE == 3) {
#pragma unroll
        for (int i = 0; i < 2; ++i) { const int tt = 2 * w + i, di = tt >> 2, ei = tt & 3;
#pragma unroll
            for (int g = 0; g < 16; ++g) upd[i][g] = a.Sprev[(32 * di + crow(g, h)) * 128 + 32 * ei + r]; }
        const float* sp0 = a.Sprev + (8 * h) * 128 + 32 * (w & 3) + r;
#pragma unroll
        for (int s = 0; s < 8; ++s)
#pragma unroll
            for (int j = 0; j < 8; ++j) sv[s][j] = sp0[(16 * s + j) * 128];
    }
    if (MODE & 1) {
#pragma unroll
        for (int i = 0; i < 2; ++i) {
            const int tt = 2 * w + i, di = tt >> 2, ei = tt & 3;
            f32x16 acc = zero16();
            if (MODE == 1) {
#pragma unroll
                for (int s = 0; s < 4; ++s) acc = MFMA32(tr8(VV, 16 * s + 8 * h, 16 * s + 8 * h + 4, ei, lane), tr8(KS, 16 * s + 8 * h, 16 * s + 8 * h + 4, di, lane), acc);
                const bool odd = (r & 1) != 0;
#pragma unroll
                for (int g2 = 0; g2 < 8; ++g2) {
                    const float m0 = acc[2 * g2], m1 = acc[2 * g2 + 1];
                    const float rv = __shfl_xor(odd ? m0 : m1, 1);
                    const unsigned word = odd ? pk2(rv, m1) : pk2(m0, rv);
                    const int e = 32 * ei + crow(2 * g2, h) + (odd ? 1 : 0);
                    st_wt32((unsigned*)(a.dSout + e * 128 + 32 * di + (r & ~1)), word);
                }
            } else {
#pragma unroll
                for (int s = 0; s < 4; ++s) acc = MFMA32(tr8(KS, 16 * s + 8 * h, 16 * s + 8 * h + 4, di, lane), tr8(VV, 16 * s + 8 * h, 16 * s + 8 * h + 4, ei, lane), acc);
#pragma unroll
                for (int g = 0; g < 16; ++g) { const int d = 32 * di + crow(g, h); const float dec = (MIXER == 0) ? decay_s : fexp(G[63 * 128 + d]);
                    a.Sout[d * 128 + 32 * ei + r] = dec * upd[i][g] + acc[g]; }
            }
        }
    }
    if (MODE & 2) {
        const int li = w >> 2, ei = w & 3;
        f32x16 O = zero16();
#pragma unroll
        for (int s = 0; s < 8; ++s) {
            bf16x8 bop;
            if (MODE == 2) { u32x4 bw; bw.x = (unsigned)svq[s][0]; bw.y = (unsigned)(svq[s][0] >> 32); bw.z = (unsigned)svq[s][1]; bw.w = (unsigned)(svq[s][1] >> 32); bop = __builtin_bit_cast(bf16x8, bw); }
            else bop = pack8(sv[s][0], sv[s][1], sv[s][2], sv[s][3], sv[s][4], sv[s][5], sv[s][6], sv[s][7]);
            O = MFMA32(ld_row(QI, 32 * li + r, s, h), bop, O);
        }
        for (int mi = 0; mi <= li; ++mi) {
            f32x16 X = zero16();
#pragma unroll
            for (int s = 0; s < 8; ++s) X = MFMA32(ld_row(KT, 32 * mi + r, s, h), ld_row(QT, 32 * li + r, s, h), X);
            if (mi == li) {
#pragma unroll
                for (int g = 0; g < 16; ++g) X[g] = (crow(g, h) <= r) ? X[g] : 0.f;
            }
            const bf16x8 pa0 = pack8(X[0], X[1], X[2], X[3], X[4], X[5], X[6], X[7]), pa1 = pack8(X[8], X[9], X[10], X[11], X[12], X[13], X[14], X[15]);
            O = MFMA32(pa0, tr8(VV, 32 * mi + 4 * h, 32 * mi + 8 + 4 * h, ei, lane), O);
            O = MFMA32(pa1, tr8(VV, 32 * mi + 16 + 4 * h, 32 * mi + 24 + 4 * h, ei, lane), O);
        }
        __syncthreads();
#pragma unroll
        for (int g = 0; g < 16; ++g) G[(32 * li + crow(g, h)) * 128 + 32 * ei + r] = O[g];
        __syncthreads();
        const int l = tid >> 3, e0 = 16 * (tid & 7);
        float o[16]; float ss = 0.f;
#pragma unroll
        for (int q4 = 0; q4 < 4; ++q4) { const f32x4 t = *(LAS const f32x4*)(G + l * 128 + e0 + 4 * q4); o[4 * q4] = t[0]; o[4 * q4 + 1] = t[1]; o[4 * q4 + 2] = t[2]; o[4 * q4 + 3] = t[3];
            ss += (t[0] * t[0] + t[1] * t[1]) + (t[2] * t[2] + t[3] * t[3]); }
        ss += __shfl_xor(ss, 1); ss += __shfl_xor(ss, 2); ss += __shfl_xor(ss, 4);
        const float rstd = __builtin_amdgcn_rsqf(ss * (1.0f / 128.0f) + EPS);
        float y[16];
#pragma unroll
        for (int jj = 0; jj < 16; ++jj) {
            const unsigned wg = (jj < 8) ? gw0[jj >> 1] : gw1[(jj - 8) >> 1];
            const float gt = (jj & 1) ? bfhi(wg) : bflo(wg);
            const float sg = sigmoidf_(gt);
            const float gate = (MIXER == 0) ? gt * sg : sg;
            y[jj] = o[jj] * rstd * ngv[jj >> 2][jj & 3] * gate;
        }
        u32x4 p0, p1; p0.x = pk2(y[0], y[1]); p0.y = pk2(y[2], y[3]); p0.z = pk2(y[4], y[5]); p0.w = pk2(y[6], y[7]);
        p1.x = pk2(y[8], y[9]); p1.y = pk2(y[10], y[11]); p1.z = pk2(y[12], y[13]); p1.w = pk2(y[14], y[15]);
        bf16* mo = a.mixo + (size_t)l * 2048 + e0;
        *(u32x4*)(mo) = p0; *(u32x4*)(mo + 8) = p1;
    }
    if (MODE != 3 && cvon) tr_store(cvt, cvv);
#undef LA_ST
#undef LA_ST2
}
template <int WIN>
DI void pool_win(const float (&u)[31], LAS unsigned char* P, const int seg, const int c, const bool prompt, const int row0) {
#pragma unroll
    for (int k = 0; k < 16; ++k) {
        float s = 0.f;
#pragma unroll
        for (int j = 0; j < WIN; ++j) s += u[k + 15 - j];
        const int t = 16 * seg + k, pos = prompt ? (row0 + t) : (PAST + t);
        const float cnt = (float)((pos + 1 < WIN) ? pos + 1 : WIN);
        const float p = s / cnt - u[k + 15];
        *(LAS unsigned short*)(P + RS * t + 2 * c) = (unsigned short)(pk2(p, 0.f) & 0xffffu);
    }
}
DI void pool_item(LAS unsigned char* lds, const bf16* z, const float* state_pool_l, const bf16* pwt_l, bf16* mix, const int ti, const int g, const ConvCtx& cvx, const int cv_l, const int cv_wi, const int tid_in) {
    int tid = tid_in; asm volatile("" : "+v"(tid));
    const int lane = tid & 63, w = __builtin_amdgcn_readfirstlane(tid >> 6), r = lane & 31, h = lane >> 5;
    LAS float* U = (LAS float*)lds;
    LAS unsigned char* P = lds + 49152;
    const bool prompt = ti < 128; const int row0 = prompt ? 64 * ti : 8192 + 64 * (ti - 128);
    TrItem cvt; f32x4 cvv[16];
    const bool cvon = conv_list_setup(cvt, cvx, cv_l, cv_wi >= 0 ? cv_wi + w : -1, lane);
    if (cv_wi >= 0) tr_load(cvt, cvv); else { for (int i = 0; i < 16; ++i) cvv[i] = (f32x4){0.f, 0.f, 0.f, 0.f}; }
    for (int n = tid; n < 79 * 16; n += 512) {
        const int j = n >> 4, ch = n & 15; float v[8];
        const int trow = row0 + j - 15;
        if (j >= 15 || (prompt && trow >= 0)) {
            const u32x4 t = *(const u32x4*)(z + (size_t)trow * 6144 + 7 * 512 + 128 * g + 8 * ch);
            v[0] = bflo(t.x); v[1] = bfhi(t.x); v[2] = bflo(t.y); v[3] = bfhi(t.y); v[4] = bflo(t.z); v[5] = bfhi(t.z); v[6] = bflo(t.w); v[7] = bfhi(t.w);
        } else if (!prompt) {
            const float* sp = state_pool_l + ((size_t)(ti - 128) * 15 + j) * 512 + 128 * g + 8 * ch;
            const f32x4 a = *(const f32x4*)sp, b = *(const f32x4*)(sp + 4);
            v[0] = a[0]; v[1] = a[1]; v[2] = a[2]; v[3] = a[3]; v[4] = b[0]; v[5] = b[1]; v[6] = b[2]; v[7] = b[3];
        } else {
#pragma unroll
            for (int i = 0; i < 8; ++i) v[i] = 0.f;
        }
        *(LAS f32x4*)(U + j * 128 + 8 * ch) = (f32x4){v[0], v[1], v[2], v[3]}; *(LAS f32x4*)(U + j * 128 + 8 * ch + 4) = (f32x4){v[4], v[5], v[6], v[7]};
    }
    __syncthreads();
    {   const int c = tid & 127, seg = tid >> 7;
        float u[31];
#pragma unroll
        for (int i = 0; i < 31; ++i) u[i] = U[(16 * seg + i) * 128 + c];
        switch (g) {
            case 0: pool_win<2>(u, P, seg, c, prompt, row0); break;
            case 1: pool_win<4>(u, P, seg, c, prompt, row0); break;
            case 2: pool_win<8>(u, P, seg, c, prompt, row0); break;
            default: pool_win<16>(u, P, seg, c, prompt, row0); break;
        }
    }
    __syncthreads();
    const int ti2 = w >> 2, di = w & 3;
    f32x16 acc = zero16();
    const bf16* wb = pwt_l + ((size_t)g * 128 + 32 * di + r) * 128 + 8 * h;
#pragma unroll
    for (int s = 0; s < 8; ++s) acc = MFMA32(ld_row(P, 32 * ti2 + r, s, h), *(const bf16x8*)(wb + 16 * s), acc);
#pragma unroll
    for (int i = 0; i < 16; ++i) mix[(size_t)(row0 + 32 * ti2 + crow(i, h)) * 2048 + 1024 + 128 * g + 32 * di + r] = (unsigned short)(pk2(acc[i], 0.f) & 0xffffu);
    if (cvon) tr_store(cvt, cvv);
}

DI float wave_sum(float v) {
#pragma unroll
    for (int o = 1; o < 64; o <<= 1) v += __shfl_xor(v, o);
    return v;
}
constexpr int NWAVES_ = 8;
DI void splitk_fixup(bf16* XB, float* ssq, const bf16* slab, const pg8::SplitOrder& S, const int bx, const int tid_in) {
    int tid = tid_in; asm volatile("" : "+v"(tid));
    const int lane = tid & 63, wave = tid >> 6;
    for (int it0 = (bx * NWAVES_ + wave) * 4; it0 < 64 * 256; it0 += 256 * NWAVES_ * 4) {
        u32x2 rr[4], p0[4], p1[4], p2[4], p3[4]; size_t offs[4]; int rows[4], pns[4];
#pragma unroll
        for (int q = 0; q < 4; ++q) {
            const int it = it0 + q, s = it >> 8, r = it & 255;
            pg8::Unit u; S.tile_of(256 + s, u);
            const int row = u.pm * 256 + r, col = u.pn * 256 + 4 * lane;
            const size_t off = (size_t)row * 2048 + col; offs[q] = off; rows[q] = row; pns[q] = u.pn;
            const bf16* sp = slab + ((size_t)(s * 4) * 256 + r) * 256 + 4 * lane;
            rr[q] = *(const u32x2*)(XB + off); p0[q] = *(const u32x2*)(sp); p1[q] = *(const u32x2*)(sp + 65536); p2[q] = *(const u32x2*)(sp + 2 * 65536); p3[q] = *(const u32x2*)(sp + 3 * 65536);
        }
#pragma unroll
        for (int q = 0; q < 4; ++q) {
            const f32x4 rf = {bflo(rr[q].x), bfhi(rr[q].x), bflo(rr[q].y), bfhi(rr[q].y)};
#define F4_(v) ((f32x4){bflo((v).x), bfhi((v).x), bflo((v).y), bfhi((v).y)})
            const f32x4 o = rf + (((F4_(p0[q]) + F4_(p1[q])) + F4_(p2[q])) + F4_(p3[q]));
#undef F4_
            u32x2 w; w.x = pk2(o[0], o[1]); w.y = pk2(o[2], o[3]); *(u32x2*)(XB + offs[q]) = w;
            float qq = (o[0] * o[0] + o[1] * o[1]) + (o[2] * o[2] + o[3] * o[3]);
            qq += __shfl_xor(qq, 1); qq += __shfl_xor(qq, 2); qq += __shfl_xor(qq, 4); qq += __shfl_xor(qq, 8);
            if ((lane & 15) == 0) ssq[(size_t)rows[q] * 32 + pns[q] * 4 + (lane >> 4)] = qq;
        }
    }
}
constexpr int NWAVES = 8;
#ifndef G1_CV
#define G1_CV 0
#endif
#ifndef G1_WGM
#define G1_WGM 8
#endif
#ifndef G3_WGM
#define G3_WGM 8
#endif
#ifndef REP_M1_MASK
#define REP_M1_MASK 63
#endif
#define M1_RUN(bit) (rep == 0 || (REP_M1_MASK & (bit)))
#ifndef GEMM_ALIGN
#define GEMM_ALIGN true
#endif
#ifndef GEMM_SP2
#define GEMM_SP2 true
#endif
#ifndef REP_P0
#define REP_P0 1
#endif
#ifndef REP_G1
#define REP_G1 1
#endif
#ifndef REP_M1
#define REP_M1 1
#endif
#ifndef REP_M3
#define REP_M3 1
#endif
#ifndef REP_G3
#define REP_G3 1
#endif
constexpr int NPHASE = 2 + 7 * NL;
struct Args { const float* in[19]; float* out; unsigned char* ws; int ph_lo, ph_hi; };
static_assert(sizeof(Args) == 19 * 8 + 8 + 8 + 8, "Args has no padding holes");

__global__ void __launch_bounds__(NWAVES * 64, 2) fwd(Args args) {
    extern __shared__ __attribute__((aligned(16))) unsigned char lds_raw[];
    LAS unsigned char* lds = (LAS unsigned char*)lds_raw;
    volatile LAS unsigned* MISC = (volatile LAS unsigned*)(lds + LDS_CTL_OFF);
    const int tid0 = threadIdx.x;
#define PHASE_TID() int tid = tid0; asm volatile("" : "+v"(tid)); const int lane = tid & 63, wave = __builtin_amdgcn_readfirstlane(tid >> 6); (void)lane; (void)wave
    const int G = gridDim.x, bx = blockIdx.x;
    unsigned char* ws = args.ws;
    unsigned* ctl = (unsigned*)(ws + WS_CTL);
    float* ssq = (float*)(ws + WS_SSQ);
    bf16* WinT = (bf16*)(ws + WS_WIN); bf16* WoutT = (bf16*)(ws + WS_WOUT); bf16* WupT = (bf16*)(ws + WS_WUP); bf16* WdnT = (bf16*)(ws + WS_WDN);
    bf16* PoolWT = (bf16*)(ws + WS_POOLW); bf16* XB = (bf16*)(ws + WS_XB); bf16* Z = (bf16*)(ws + WS_Z);
    bf16* MIX = (bf16*)(ws + WS_MIX); bf16* UU = (bf16*)(ws + WS_U); bf16* DSB = (bf16*)(ws + WS_DS); float* HDEC = (float*)(ws + WS_HDEC); bf16* SLAB = (bf16*)(ws + WS_SLAB); float* LB = (float*)(ws + WS_LB); float* ONES = (float*)(ws + WS_LB + 65536);
    const float* x_prompt = args.in[0]; const float* x_sample = args.in[1]; const float* state_ret = args.in[2]; const float* cache_k = args.in[3]; const float* cache_v = args.in[4];
    const float* state_pool = args.in[5]; const float* state_hgrn = args.in[6]; const float* norm1_g = args.in[7]; const float* w_in = args.in[8]; const float* ret_norm_g = args.in[9];
    const float* pool_w = args.in[10]; const float* pool_scale = args.in[11]; const float* hg_lb = args.in[12]; const float* hg_norm_g = args.in[13]; const float* w_out = args.in[14];
    const float* norm2_g = args.in[15]; const float* w_up = args.in[16]; const float* w_down = args.in[17]; const float* final_g = args.in[18];
    float* out = args.out;
    const ConvCtx cvx{w_in, w_out, w_up, w_down, norm1_g, norm2_g, ONES, WinT, WoutT, WupT, WdnT};

    for (int u = tid0; u < (LDS_BYTES - LDS_CTL_OFF) / 4; u += NWAVES * 64) ((LAS unsigned*)(lds + LDS_CTL_OFF))[u] = 0u;
    __syncthreads();
#if MK_PER_PHASE
#define GRID_BAR() do { } while (0)
#else
    XcdBarrier bar = xcd_barrier_post(ctl + CW_BAR, MISC + 8);
#ifndef REP_BAR
#define REP_BAR 1
#endif
#define GRID_BAR() do { for (int rb_ = 0; rb_ < REP_BAR; ++rb_) xcd_barrier(bar); } while (0)
#endif
    volatile LAS int* wq_slot = (volatile LAS int*)(MISC + 16);
    const int lo = args.ph_lo, hi = args.ph_hi;
#define IN(k) (lo <= (k) && (k) < hi)
#ifdef PH_PROBE
#define SEAM(k) do { if (IN(k) && IN((k) + 1)) GRID_BAR(); if (tid0 == 0) MISC[64 + (k)] = (unsigned)__builtin_amdgcn_s_memrealtime(); } while (0)
#else
#define SEAM(k) do { if (IN(k) && IN((k) + 1)) GRID_BAR(); } while (0)
#endif

    if (IN(0)) for (int rep = 0; rep < REP_P0; ++rep) {
        PHASE_TID();
        const int gw = bx * NWAVES + wave, NGW = G * NWAVES;
        for (int it = 2 * gw; it < CV_IN; it += 2 * NGW) conv_wave_pair(w_in, w_out, w_up, w_down, norm1_g, norm2_g, ONES, WinT, WoutT, WupT, WdnT, 0, it, 0, it + 1, lane);
        for (int i = bx * 512 + tid; i < NL * 4 * 128 * 128; i += G * 512) {
            const int c = i & 127, d = (i >> 7) & 127, g = (i >> 14) & 3, l = i >> 16;
            PoolWT[i] = (unsigned short)(pk2(pool_w[(((size_t)l * 4 + g) * 128 + c) * 128 + d] * pool_scale[l * 512 + 128 * g + d], 0.f) & 0xffffu);
        }
        for (int i = bx * 512 + tid; i < DFF; i += G * 512) ONES[i] = 1.0f;
        for (int i = bx * 512 + tid; i < 512; i += G * 512) {
            const float b0 = hg_lb[i], b1 = hg_lb[512 + i], b2 = hg_lb[1024 + i], b3 = hg_lb[1536 + i];
            const float mx = fmaxf(fmaxf(b0, b1), fmaxf(b2, b3));
            const float e0 = fexp(b0 - mx), e1 = fexp(b1 - mx), e2 = fexp(b2 - mx), e3 = fexp(b3 - mx), den = (e0 + e1) + (e2 + e3);
            LB[i] = 0.f; LB[512 + i] = e1 / den; LB[1024 + i] = (e1 + e2) / den; LB[1536 + i] = ((e1 + e2) + e3) / den;
        }
        for (int m = gw; m < MR; m += NGW) {
            const float* xr = (m < TP) ? x_prompt + (size_t)m * DM : x_sample + (size_t)(m - TP) * DM;
            float s = 0.f; f32x4 xv[8];
#pragma unroll
            for (int j = 0; j < 8; ++j) xv[j] = *(const f32x4*)(xr + 4 * lane + 256 * j);
#pragma unroll
            for (int j = 0; j < 8; ++j) { const f32x4 v = xv[j]; s += (v[0] * v[0] + v[1] * v[1]) + (v[2] * v[2] + v[3] * v[3]);
                u32x2 p; p.x = pk2(v[0], v[1]); p.y = pk2(v[2], v[3]); *(u32x2*)(XB + (size_t)m * DM + 4 * lane + 256 * j) = p; }
            s = wave_sum(s);
            if (lane < 32) ssq[(size_t)m * 32 + lane] = (lane == 0) ? s : 0.f;
        }
    }
    SEAM(0);

    for (int l = 0; l < NL; ++l) {
        const int pb = 1 + 7 * l;
        int bxl = bx; asm volatile("" : "+s"(bxl));
        float* ssq1 = ssq + (size_t)(2 * l) * MR * 32; float* ssq2 = ssq + (size_t)(2 * l + 1) * MR * 32; float* ssq3 = ssq + (size_t)(2 * l + 2) * MR * 32;
        if (IN(pb)) for (int rep = 0; rep < REP_G1; ++rep) {
            pg8::Gemm g{XB, WinT + (size_t)l * DIN * DM, MR, DIN, DM}; pg8::StaticOrder S; S.init(MR, DIN, G, bxl, DM, G1_WGM);
            pg8::EpiIn E{Z, ssq1,
                         out + O_POOLP + (size_t)l * 15 * 512, out + O_POOLS + (size_t)l * NB * 15 * 512};
            pg8::gemm_phase<pg8::EpiIn, pg8::StaticOrder, GEMM_ALIGN, GEMM_SP2>(lds, g, S, E);
            if (G == 256 && bxl >= 192) {
                PHASE_TID();
                const int w0 = ((bxl - 192) * NWAVES + wave) * (G1_CV / 512);
                for (int i = 0; i < G1_CV / 512; i += 2) {
                    TrItem t0, t1; f32x4 v0[16], v1[16];
                    const bool on0 = conv_list_setup(t0, cvx, l, w0 + i, lane); tr_load(t0, v0);
                    const bool on1 = conv_list_setup(t1, cvx, l, w0 + i + 1, lane); tr_load(t1, v1);
                    if (on0) tr_store(t0, v0);
                    if (on1) tr_store(t1, v1);
                }
            }
        }
        SEAM(pb);
        if (IN(pb + 1)) {
            PHASE_TID();
            unsigned* qctr = ctl + CW_Q + 64 * (2 * l);
            unsigned* dep = ctl + CW_DEP + (l * 16) * 64; unsigned* tmo = ctl;
            int wq_pre = wq_claim(qctr), wq_par = 0;
            unsigned* pend = nullptr;
            unsigned seen = 0u;
            for (;;) {
#ifdef PH_PROBE
                if (l == 1 && tid == 0) { const int q_ = wq_pre; const int k_ = q_ == 256 ? 0 : q_ == 1280 ? 1 : q_ == 1408 ? 2 : q_ == 1664 ? 3 : q_ == 2304 ? 4 : q_ == 3328 ? 5 : -1;
                    if (k_ >= 0) __hip_atomic_store(ctl + 24576 + k_, (unsigned)__builtin_amdgcn_s_memrealtime(), __ATOMIC_RELAXED, __HIP_MEMORY_SCOPE_AGENT); }
#endif
                const int it = wq_next(qctr, wq_slot, wq_pre, wq_par);
                if (it >= 3328) break;
                if ((it >= 256 && it < 1280) || (it >= 1408 && it < 1664) || it >= 2304) {
                    LaArgs a; int mixer; a.tmo = tmo; a.dep_done = nullptr; a.dep_need = nullptr; a.cv_wi = -1; a.pub_prev = pend;
                    if (it < 1280) { const int k = it - 256; mixer = k >> 9; const int rem = k & 511, hh = rem >> 7, c = rem & 127;
                        a.z = Z + (size_t)(64 * c) * DIN; a.h = hh; a.pos0 = 64 * c; a.mode = 1; a.prompt = 1;
                        a.Sprev = nullptr; a.SpT = nullptr; a.dSout = DSB + ((size_t)(mixer * 4 + hh) * 128 + c) * 16384; a.Sout = nullptr; a.hdec = HDEC + ((size_t)hh * 128 + c) * 128;
                        a.mixo = nullptr; a.cv_wi = (G1_CV + 3072 + 8 * k < 12288) ? G1_CV + 3072 + 8 * k : -1; a.dep_done = dep + (mixer * 4 + hh) * 64;
                    } else if (it < 1664) { const int k = it - 1408; mixer = k >> 7; const int rem = k & 127, b = rem >> 2, hh = rem & 3;
                        a.z = Z + (size_t)(TP + 64 * b) * DIN; a.h = hh; a.pos0 = PAST; a.mode = 3; a.prompt = 0;
                        a.Sprev = (mixer == 0 ? state_ret : state_hgrn) + ((size_t)(l * NB + b) * 4 + hh) * 16384; a.SpT = nullptr; a.dSout = nullptr;
                        a.Sout = out + (mixer == 0 ? O_RETS : O_HGS) + ((size_t)(l * NB + b) * 4 + hh) * 16384; a.hdec = nullptr;
                        a.mixo = MIX + (size_t)(TP + 64 * b) * DM + (mixer == 0 ? 0 : 1536) + hh * 128;
                    } else { const int k = it - 2304; mixer = k >> 9; const int rem = k & 511, hh = rem >> 7, c = rem & 127;
                        a.z = Z + (size_t)(64 * c) * DIN; a.h = hh; a.pos0 = 64 * c; a.mode = 2; a.prompt = 1;
                        a.Sprev = nullptr; a.SpT = DSB + ((size_t)(mixer * 4 + hh) * 128 + c) * 16384; a.dSout = nullptr; a.Sout = nullptr; a.hdec = nullptr;
                        a.mixo = MIX + (size_t)(64 * c) * DM + (mixer == 0 ? 0 : 1536) + hh * 128;
                        const int mh = mixer * 4 + hh; a.dep_need = ((seen >> mh) & 1u) ? nullptr : dep + (8 + mh) * 64; seen |= 1u << mh;
                    }
                    a.ng = (mixer == 0 ? ret_norm_g : hg_norm_g) + l * 512 + a.h * 128; a.lbsrc = LB + l * 512; a.layer = l;
                    if (it < 1280) { if (mixer == 0) la_item<0, 1>(lds, a, cvx, tid); else la_item<1, 1>(lds, a, cvx, tid); }
                    else if (it < 1664) { if (mixer == 0) la_item<0, 3>(lds, a, cvx, tid); else la_item<1, 3>(lds, a, cvx, tid); }
                    else { if (mixer == 0) la_item<0, 2>(lds, a, cvx, tid); else la_item<1, 2>(lds, a, cvx, tid); }
                    pend = a.dep_done;
                } else if (it < 256) {
                    if (pend) { dep_publish(pend); pend = nullptr; }
                    const int k = it; SbArgs a;
                    if (k < 128) { const int b = k >> 2, hh = k & 3; const size_t zr = (size_t)(TP + 64 * b) * DIN;
                        a.zq = Z + zr + 4 * 512 + hh * 128; a.zk = Z + zr + 5 * 512 + hh * 128; a.zv = Z + zr + 6 * 512 + hh * 128;
                        a.kc = cache_k + ((size_t)(l * NB + b) * PAST) * 512 + hh * 128; a.vc = cache_v + ((size_t)(l * NB + b) * PAST) * 512 + hh * 128;
                        a.nf32 = 64; a.t_hi = 64; a.qpos0 = PAST; a.nqw = 2; a.mixo = MIX + (size_t)(TP + 64 * b) * DM + 512 + hh * 128;
                        a.ok = out + O_SBKS + ((size_t)l * 2048 + 64 * b) * 512 + hh * 128; a.ovd = (int)(O_SBVS - O_SBKS); a.own_lo = 64;
                    } else { const int k2 = k - 128, qi = 31 - (k2 >> 2), hh = k2 & 3;
                        a.zq = Z + (size_t)(256 * qi) * DIN + 4 * 512 + hh * 128; a.zk = Z + 5 * 512 + hh * 128; a.zv = Z + 6 * 512 + hh * 128;
                        a.kc = cache_k; a.vc = cache_v; a.nf32 = 0; a.t_hi = 4 * qi + 3; a.qpos0 = 256 * qi; a.nqw = 8; a.mixo = MIX + (size_t)(256 * qi) * DM + 512 + hh * 128;
                        a.ok = out + O_SBKP + (size_t)l * TP * 512 + hh * 128; a.ovd = (int)(O_SBVP - O_SBKP); a.own_lo = 4 * qi;
                    }
                    sb_item(lds, a, cvx, l, (k < 128) ? G1_CV + 24 * k : -1, tid);
                } else if (it < 1408) {
                    int tq = tid; asm volatile("" : "+v"(tq));
                    const int s = it - 1280, mh = s >> 4, mixer = mh >> 2, hh = mh & 3, pidx = (s & 15) * 512 + tq, d = (2 * pidx) & 127, e = (2 * pidx) >> 7;
                    if (pend) { dep_publish(pend); pend = nullptr; }
                    dep_wait_sc1(dep + mh * 64, 128u, tmo);
                    unsigned* base = (unsigned*)DSB + (size_t)mh * 128 * 8192 + pidx;
                    const float dret = fexp2(64.0f * flog2(1.0f - fexp2(-5.0f - (float)hh)));
                    LAS float* H = (LAS float*)lds;
                    if (mixer == 1) {
                        const unsigned long long* hsrc = (const unsigned long long*)(HDEC + (size_t)hh * 16384);
#pragma unroll
                        for (int i = 0; i < 16; ++i) { const unsigned long long v = ld_wt64(hsrc + tq + 512 * i); *(LAS unsigned long long*)(H + 2 * (tq + 512 * i)) = v; }
                        __syncthreads();
                    }
                    float st0 = 0.f, st1 = 0.f;
                    for (int c0 = 0; c0 < 128; c0 += 64) {
                        unsigned t[64];
#pragma unroll
                        for (int c = 0; c < 64; ++c) t[c] = ld_wt32(base + (size_t)(c0 + c) * 8192);
                        if (mixer == 0) {
#pragma unroll
                            for (int c = 0; c < 64; ++c) { st_wt32(base + (size_t)(c0 + c) * 8192, pk2(st0, st1)); st0 = dret * st0 + bflo(t[c]); st1 = dret * st1 + bfhi(t[c]); }
                        } else {
#pragma unroll
                            for (int c = 0; c < 64; ++c) { st_wt32(base + (size_t)(c0 + c) * 8192, pk2(st0, st1)); const float dc0 = H[(c0 + c) * 128 + d], dc1 = H[(c0 + c) * 128 + d + 1];
                                st0 = dc0 * st0 + bflo(t[c]); st1 = dc1 * st1 + bfhi(t[c]); }
                        }
                    }
                    float* fo = out + (mixer == 0 ? O_RETP : O_HGP) + ((size_t)l * 4 + hh) * 16384;
                    fo[d * 128 + e] = st0; fo[(d + 1) * 128 + e] = st1;
                    pend = dep + (8 + mh) * 64;
                } else {
                    const int k = it - 1664;
                    if (pend) { dep_publish(pend); pend = nullptr; }
                    pool_item(lds, Z, state_pool + (size_t)l * NB * 15 * 512, PoolWT + (size_t)l * 4 * 128 * 128, MIX, k >> 2, k & 3, cvx, l, (G1_CV + 11264 + 8 * k < 12288) ? G1_CV + 11264 + 8 * k : -1, tid);
                }
            }
            if (pend) dep_publish(pend);
        }
        SEAM(pb + 1);
        if (IN(pb + 4)) {
            pg8::Gemm g{MIX, WoutT + (size_t)l * DM * DM, MR, DM, DM};
            pg8::EpiRes E{XB, ssq2, SLAB, bxl >> 2};
            if (G == 256) { pg8::SplitOrder S; S.init(MR, DM, G, bxl, DM, 5); pg8::gemm_phase<pg8::EpiRes, pg8::SplitOrder, GEMM_ALIGN, GEMM_SP2>(lds, g, S, E);
                GRID_BAR(); splitk_fixup(XB, ssq2, SLAB, S, bxl, tid0); }
            else { pg8::StaticOrder S; S.init(MR, DM, G, bxl, DM); pg8::gemm_phase<pg8::EpiRes, pg8::StaticOrder, GEMM_ALIGN, GEMM_SP2>(lds, g, S, E); }
        }
        SEAM(pb + 4);
        if (IN(pb + 5)) for (int rep = 0; rep < REP_G3; ++rep) {
            if (rep) GRID_BAR();
            pg8::Gemm g{XB, WupT + (size_t)l * DFF * DM, MR, DFF, DM}; pg8::StaticOrder S; S.init(MR, DFF, G, bxl, DM, G3_WGM);
            pg8::EpiUp E{UU, ssq2, DFF};
            pg8::gemm_phase<pg8::EpiUp, pg8::StaticOrder, GEMM_ALIGN, GEMM_SP2>(lds, g, S, E);
        }
        SEAM(pb + 5);
        if (IN(pb + 6)) {
            pg8::Gemm g{UU, WdnT + (size_t)l * DM * DFF, MR, DM, DFF};
            pg8::EpiRes E{XB, ssq3, SLAB, bxl >> 2};
            if (G == 256) { pg8::SplitOrder S; S.init(MR, DM, G, bxl, DFF, 5); pg8::gemm_phase<pg8::EpiRes, pg8::SplitOrder, GEMM_ALIGN, GEMM_SP2>(lds, g, S, E);
                GRID_BAR(); splitk_fixup(XB, ssq3, SLAB, S, bxl, tid0); }
            else { pg8::StaticOrder S; S.init(MR, DM, G, bxl, DFF); pg8::gemm_phase<pg8::EpiRes, pg8::StaticOrder, GEMM_ALIGN, GEMM_SP2>(lds, g, S, E); }
        }
        SEAM(pb + 6);
    }
    if (IN(NPHASE - 1)) {
        PHASE_TID();
        const float* sf = ssq + (size_t)(2 * NL) * MR * 32;
        const int gw = bx * NWAVES + wave, NGW = G * NWAVES;
        for (int m = gw; m < MR; m += NGW) {
            const float sq = wave_sum(lane < 32 ? sf[(size_t)m * 32 + lane] : 0.f);
            const float rs = __builtin_amdgcn_rsqf(sq * (1.0f / 2048.0f) + EPS);
            const bf16* xr = XB + (size_t)m * DM; float* yr = out + O_Y + (size_t)m * DM;
            u32x4 xv[4];
#pragma unroll
            for (int j = 0; j < 4; ++j) xv[j] = *(const u32x4*)(xr + 8 * lane + 512 * j);
#pragma unroll
            for (int j = 0; j < 4; ++j) { const f32x4 g0 = *(const f32x4*)(final_g + 8 * lane + 512 * j), g1 = *(const f32x4*)(final_g + 8 * lane + 512 * j + 4);
                const f32x4 v0 = {bflo(xv[j].x), bfhi(xv[j].x), bflo(xv[j].y), bfhi(xv[j].y)}, v1 = {bflo(xv[j].z), bfhi(xv[j].z), bflo(xv[j].w), bfhi(xv[j].w)};
                *(f32x4*)(yr + 8 * lane + 512 * j) = v0 * rs * g0; *(f32x4*)(yr + 8 * lane + 512 * j + 4) = v1 * rs * g1; }
        }
    }
#ifdef PH_PROBE
    if (bx == 0 && tid0 == 0) {
#define PH_T(i) ((i) >= 100 ? __hip_atomic_load(ctl + 24576 + ((i) - 100), __ATOMIC_RELAXED, __HIP_MEMORY_SCOPE_AGENT) : (unsigned)MISC[64 + (i)])
        const unsigned d = PH_T(PH_B) - PH_T(PH_A);
        const unsigned long long t_end = __builtin_amdgcn_s_memrealtime() + (unsigned long long)d * PH_FACT;
        while (__builtin_amdgcn_s_memrealtime() < t_end) __builtin_amdgcn_s_sleep(20);
    }
#endif
#undef IN
#undef SEAM
#undef GRID_BAR
}

extern "C" void kernel_launch(void* const* d_in, const int* in_sizes, int n_in, void* d_out, int out_size, void* d_ws, size_t ws_size, hipStream_t stream) {
    static int grid = 0;
    if (grid == 0) {
        if (n_in != 19 || (size_t)out_size != O_END || ws_size < WS_END) { fprintf(stderr, "kernel_launch: unexpected shapes: n_in %d out %d ws %zu (need %zu, %zu)\n", n_in, out_size, ws_size, (size_t)O_END, (size_t)WS_END); grid = -1; return; }
        int dev = 0, cus = 0, per_cu = 0;
        if (hipGetDevice(&dev) != hipSuccess || hipDeviceGetAttribute(&cus, hipDeviceAttributeMultiprocessorCount, dev) != hipSuccess) { grid = -1; return; }
        if (hipFuncSetAttribute((const void*)fwd, hipFuncAttributeMaxDynamicSharedMemorySize, LDS_BYTES) != hipSuccess) { fprintf(stderr, "kernel_launch: hipFuncSetAttribute failed\n"); grid = -1; return; }
        if (hipOccupancyMaxActiveBlocksPerMultiprocessor(&per_cu, (const void*)fwd, NWAVES * 64, LDS_BYTES) != hipSuccess || per_cu < 1) fprintf(stderr, "kernel_launch: occupancy query reports %d\n", per_cu);
        (void)hipGetLastError();
        grid = cus;
    }
    if (grid < 0) return;
    if (hipMemsetAsync((char*)d_ws + WS_CTL, 0, CTL_ZERO_BYTES, stream) != hipSuccess) { fprintf(stderr, "kernel_launch: memset failed\n"); return; }
    Args a{};
    for (int i = 0; i < 19; ++i) a.in[i] = (const float*)d_in[i];
    a.out = (float*)d_out; a.ws = (unsigned char*)d_ws;
#if MK_PER_PHASE
    for (int p = 0; p < NPHASE; ++p) { a.ph_lo = p; a.ph_hi = p + 1; hipLaunchKernelGGL(fwd, dim3(grid), dim3(NWAVES * 64), LDS_BYTES, stream, a); }
#else
    a.ph_lo = 0; a.ph_hi = NPHASE;
    hipLaunchKernelGGL(fwd, dim3(grid), dim3(NWAVES * 64), LDS_BYTES, stream, a);
#endif
    const hipError_t le = hipPeekAtLastError();
    if (le != hipSuccess) fprintf(stderr, "kernel_launch: launch failed: %s\n", hipGetErrorName(le));
}
```

```cpp
#include <hip/hip_runtime.h>
#include <cstdio>
#include <cstdint>
#ifndef MK_PER_PHASE
#define MK_PER_PHASE 0
#endif
namespace pg8 {
#define PG8_LAS __attribute__((address_space(3)))
typedef unsigned short bf16_t;
typedef short bf16x8 __attribute__((ext_vector_type(8)));
typedef float f32x4 __attribute__((ext_vector_type(4)));
typedef unsigned u32x4 __attribute__((ext_vector_type(4)));
constexpr int BM = 256, BK = 64, HALF = 128, HTB = HALF * BK * 2  , STAGE_BYTES = 8 * HTB, NXCD = 8, WGM = 8;

__host__ __device__ __forceinline__ int lds_byte(int r, int c) { const int st = (r >> 4) * 2 + (c >> 5), rr = r & 15, cc = c & 31, ob = rr * 64 + cc * 2; return st * 1024 + (ob ^ (((ob >> 9) & 1) << 5)); }
__host__ __device__ __forceinline__ void stage_rc(int b, int& R, int& C) { const int st = b / 1024, sb = b % 1024, swz = sb ^ (((sb >> 9) & 1) << 5); R = (st >> 1) * 16 + swz / 64; C = (st & 1) * 32 + (swz % 64) / 2; }
__host__ __device__ __forceinline__ int perm32(int rho) { const int n = rho >> 4, i = rho & 15; return 8 * (i >> 2) + 4 * n + (i & 3); }

struct Unit { int pm, pn, koff, nt, part; };
struct Gemm { const bf16_t* A; const bf16_t* Bt; int M, N, K; };

struct StaticOrder {
    int nM, nN, nwg, G, c, ntk, wgm;
    __host__ __device__ void init(int M, int N, int G_, int c_, int K_, int wgm_ = WGM) { nM = M / BM; nN = N / BM; nwg = nM * nN; G = G_; c = c_; ntk = K_ / BK; wgm = wgm_; }
    __host__ __device__ void tile_of(int L, Unit& u) const {
        int wgid = L; { const int q = nwg / NXCD, r = nwg % NXCD, xcd = wgid % NXCD, off = wgid / NXCD; wgid = (xcd < r ? xcd * (q + 1) : r * (q + 1) + (xcd - r) * q) + off; }
        const int nig = wgm * nN, gid = wgid / nig, fm = gid * wgm, gsz = (nM - fm) < wgm ? (nM - fm) : wgm;
        u.pm = fm + ((wgid % nig) % gsz); u.pn = (wgid % nig) / gsz; }
    __host__ __device__ bool next(int i, Unit& u) const {
        const long L = (long)i * G + c; if (L >= nwg) return false;
        int wgid = (int)L; { const int q = nwg / NXCD, r = nwg % NXCD, xcd = wgid % NXCD, off = wgid / NXCD; wgid = (xcd < r ? xcd * (q + 1) : r * (q + 1) + (xcd - r) * q) + off; }
        const int nig = wgm * nN, gid = wgid / nig, fm = gid * wgm, gsz = (nM - fm) < wgm ? (nM - fm) : wgm;
        u.pm = fm + ((wgid % nig) % gsz); u.pn = (wgid % nig) / gsz; u.koff = 0; u.nt = ntk; u.part = -1; return true;
    }
    __device__ __forceinline__ void a_ready(const Unit&) const {}
    __device__ __forceinline__ void done(const Unit&) const {}
};
struct SameTileOrder : StaticOrder {
    int nun;
    __host__ __device__ bool next(int i, Unit& u) const { if (i >= nun) return false; u.pm = 0; u.pn = 0; u.koff = 0; u.nt = ntk; u.part = -1; return true; }
};
struct SplitOrder : StaticOrder {
    __host__ __device__ bool next(int i, Unit& u) const {
        if (i == 0) { tile_of(c, u); u.koff = 0; u.nt = ntk; u.part = -1; return true; }
        if (i == 1) { tile_of(G + (c >> 2), u); u.nt = ntk / 4; u.koff = (c & 3) * (ntk / 4) * BK * 2; u.part = c & 3; return true; }
        return false;
    }
};

__device__ __forceinline__ unsigned cvt_pk_bf16(float lo, float hi) { unsigned r; asm volatile("v_cvt_pk_bf16_f32 %0, %1, %2" : "=v"(r) : "v"(lo), "v"(hi)); return r; }
typedef float f32x2 __attribute__((ext_vector_type(2)));
typedef __bf16 bf16x2_t __attribute__((ext_vector_type(2)));
__device__ __forceinline__ unsigned pk2(float a, float b) { f32x2 v = {a, b}; bf16x2_t r = __builtin_convertvector(v, bf16x2_t); return __builtin_bit_cast(unsigned, r); }

struct EpiIn {
    static constexpr bool PERM = true, AFTER_DRAIN = false;
    bf16_t* Z; const float* ssq;
    float* pool_p; float* pool_s;
    __device__ __forceinline__ void operator()(const f32x4 (&acc)[2][2][4][2], const Unit& u, int wr, int wc, int fr, int fq) const {
        asm volatile("" : "+v"(fr), "+v"(fq));
        const int row0 = u.pm * BM + wr * 64 + fr, grp = u.pn >> 1;
        const int col0 = u.pn * BM + wc * 32 + 8 * fq, cg0 = (u.pn & 1) * 256 + wc * 32 + 8 * fq;
#pragma unroll
        for (int ai = 0; ai < 2; ++ai)
#pragma unroll
            for (int m = 0; m < 4; ++m) {
                const int row = row0 + ai * HALF + m * 16;
                float sq; { const f32x4 p0 = *(const f32x4*)(ssq + (size_t)row * 32 + 8 * fq), p1 = *(const f32x4*)(ssq + (size_t)row * 32 + 8 * fq + 4);
                    sq = ((p0[0] + p0[1]) + (p0[2] + p0[3])) + ((p1[0] + p1[1]) + (p1[2] + p1[3])); sq += __shfl_xor(sq, 16); sq += __shfl_xor(sq, 32); }
                const float rs = __builtin_amdgcn_rsqf(sq * (1.0f / 2048.0f) + 1e-6f);
                bf16_t* rowp = Z + (size_t)row * 6144 + col0;
#pragma unroll
                for (int bj = 0; bj < 2; ++bj) {
                    const f32x4 v0 = acc[ai][bj][m][0] * rs, v1 = acc[ai][bj][m][1] * rs;
                    u32x4 w; w.x = pk2(v0[0], v0[1]); w.y = pk2(v0[2], v0[3]); w.z = pk2(v1[0], v1[1]); w.w = pk2(v1[2], v1[3]);
                    *(u32x4*)(rowp + bj * HALF) = w;
                    const int cg = cg0 + bj * HALF;
                    if (grp == 7) {
                        if (u.pm < 32) { if (row >= 8177) { float* dst = pool_p + (size_t)(row - 8177) * 512 + cg; *(f32x4*)(dst) = v0; *(f32x4*)(dst + 4) = v1; } }
                        else { const int rsx = row - 8192, i = rsx & 63; if (i >= 49) { float* dst = pool_s + ((size_t)(rsx >> 6) * 15 + (i - 49)) * 512 + cg; *(f32x4*)(dst) = v0; *(f32x4*)(dst + 4) = v1; } }
                    }
                }
            }
    }
};
struct EpiRes {
    static constexpr bool PERM = true, AFTER_DRAIN = false;
    bf16_t* XB; float* ssq; bf16_t* slab; int slab_id;
    __device__ __forceinline__ void operator()(const f32x4 (&acc)[2][2][4][2], const Unit& u, int wr, int wc, int fr, int fq) const {
        asm volatile("" : "+v"(fr), "+v"(fq));
        if (u.part >= 0) {
            bf16_t* sp = slab + ((size_t)(slab_id * 4 + u.part) * 256 + wr * 64 + fr) * 256 + wc * 32 + 8 * fq;
#pragma unroll
            for (int ai = 0; ai < 2; ++ai)
#pragma unroll
                for (int m = 0; m < 4; ++m)
#pragma unroll
                    for (int bj = 0; bj < 2; ++bj) { const f32x4 a0 = acc[ai][bj][m][0], a1 = acc[ai][bj][m][1];
                        u32x4 w; w.x = pk2(a0[0], a0[1]); w.y = pk2(a0[2], a0[3]); w.z = pk2(a1[0], a1[1]); w.w = pk2(a1[2], a1[3]);
                        *(u32x4*)(sp + (size_t)(ai * HALF + m * 16) * 256 + bj * HALF) = w; }
            return;
        }
        const int row0 = u.pm * BM + wr * 64 + fr, col0 = u.pn * BM + wc * 32 + 8 * fq;
        u32x4 rc[2], rn[2];
        {   const size_t off = (size_t)row0 * 2048 + col0;
#pragma unroll
            for (int bj = 0; bj < 2; ++bj) rc[bj] = *(const u32x4*)(XB + off + bj * HALF); }
#pragma unroll
        for (int ai = 0; ai < 2; ++ai)
#pragma unroll
            for (int m = 0; m < 4; ++m) {
                const int row = row0 + ai * HALF + m * 16; const size_t off = (size_t)row * 2048 + col0; float s = 0.f;
                if (ai * 4 + m < 7) { const int g1 = ai * 4 + m + 1; const size_t offn = (size_t)(row0 + (g1 >> 2) * HALF + (g1 & 3) * 16) * 2048 + col0;
#pragma unroll
                    for (int bj = 0; bj < 2; ++bj) rn[bj] = *(const u32x4*)(XB + offn + bj * HALF); }
#pragma unroll
                for (int bj = 0; bj < 2; ++bj) {
                    const u32x4 r = rc[bj];
                    const f32x4 r0 = {__uint_as_float(r.x << 16), __uint_as_float(r.x & 0xffff0000u), __uint_as_float(r.y << 16), __uint_as_float(r.y & 0xffff0000u)};
                    const f32x4 r1 = {__uint_as_float(r.z << 16), __uint_as_float(r.z & 0xffff0000u), __uint_as_float(r.w << 16), __uint_as_float(r.w & 0xffff0000u)};
                    const f32x4 o0 = r0 + acc[ai][bj][m][0], o1 = r1 + acc[ai][bj][m][1];
                    s += ((o0[0] * o0[0] + o0[1] * o0[1]) + (o0[2] * o0[2] + o0[3] * o0[3])) + ((o1[0] * o1[0] + o1[1] * o1[1]) + (o1[2] * o1[2] + o1[3] * o1[3]));
                    u32x4 w; w.x = pk2(o0[0], o0[1]); w.y = pk2(o0[2], o0[3]); w.z = pk2(o1[0], o1[1]); w.w = pk2(o1[2], o1[3]);
                    *(u32x4*)(XB + off + bj * HALF) = w;
                }
                s += __shfl_xor(s, 16); s += __shfl_xor(s, 32);
                if (fq == 0) ssq[(size_t)row * 32 + u.pn * 4 + wc] = s;
#pragma unroll
                for (int bj = 0; bj < 2; ++bj) rc[bj] = rn[bj];
            }
    }
};
template <int PM = 0> struct EpiUpT {
    static constexpr bool PERM = true, AFTER_DRAIN = false;
    bf16_t* U; const float* ssq; int ldc;
    __device__ __forceinline__ void operator()(const f32x4 (&acc)[2][2][4][2], const Unit& u, int wr, int wc, int fr, int fq) const {
        asm volatile("" : "+v"(fr), "+v"(fq));
        const int row0 = u.pm * BM + wr * 64 + fr, col0 = u.pn * BM + wc * 32 + 8 * fq;
#pragma unroll
        for (int ai = 0; ai < 2; ++ai)
#pragma unroll
            for (int m = 0; m < 4; ++m) {
                const int row = row0 + ai * HALF + m * 16;
                float sq = 2048.f; if (!(PM & 1)) { const f32x4 p0 = *(const f32x4*)(ssq + (size_t)row * 32 + 8 * fq), p1 = *(const f32x4*)(ssq + (size_t)row * 32 + 8 * fq + 4);
                    sq = ((p0[0] + p0[1]) + (p0[2] + p0[3])) + ((p1[0] + p1[1]) + (p1[2] + p1[3])); sq += __shfl_xor(sq, 16); sq += __shfl_xor(sq, 32); }
                float rs = __builtin_amdgcn_rsqf(sq * (1.0f / 2048.0f) + 1e-6f);
                bf16_t* rowp = U + (size_t)row * ldc + col0;
#pragma unroll
                for (int bj = 0; bj < 2; ++bj) {
                    f32x4 v0 = acc[ai][bj][m][0] * rs, v1 = acc[ai][bj][m][1] * rs;
#pragma unroll
                    for (int j = 0; j < 4; ++j) { const float a = fmaxf(v0[j], 0.f), b = fmaxf(v1[j], 0.f); v0[j] = a * a; v1[j] = b * b; }
                    u32x4 w; w.x = pk2(v0[0], v0[1]); w.y = pk2(v0[2], v0[3]); w.z = pk2(v1[0], v1[1]); w.w = pk2(v1[2], v1[3]);
                    if (!(PM & 2)) *(u32x4*)(rowp + bj * HALF) = w; else asm volatile("" :: "v"(w));
                }
            }
    }
};
typedef EpiUpT<0> EpiUp;
template <class Epi, class Sched, bool ALIGN_EPI = false, bool SP2 = false>
__device__ __forceinline__ void gemm_phase(PG8_LAS unsigned char* lds, const Gemm g, const Sched& S, const Epi& E) {
    int tid = threadIdx.x; asm volatile("" : "+v"(tid));
    const int wid = __builtin_amdgcn_readfirstlane(tid >> 6), lane = tid & 63, wr = wid >> 2, wc = wid & 3, fr = lane & 15, fq = lane >> 4;
    const int K = g.K;
    unsigned voffA[2], voffB[2];
#pragma unroll
    for (int i = 0; i < 2; ++i) { int R, C; stage_rc(tid * 16 + i * 8192, R, C); const int Rb = Epi::PERM ? ((R & ~31) + perm32(R & 31)) : R;
        voffA[i] = (unsigned)(R * K + C) * 2u; voffB[i] = (unsigned)(Rb * K + C) * 2u; }
    const size_t kstep = (size_t)(BK * 2);
    const size_t hstep = (size_t)HALF * K * 2;
    const size_t tstep = 2 * hstep;
    const unsigned ldsw = (unsigned)wid * 1024u;
    const int aoff = lds_byte(wr * 64 + fr, fq * 8), boff = lds_byte(wc * 32 + fr, fq * 8);
#define PG8_SA(b, h) (((b) * 2 + (h)) * HTB)
#define PG8_SB(b, h) ((4 + (b) * 2 + (h)) * HTB)
#define PG8_STAGE(bufoff, gbase, voff) do { _Pragma("unroll") for (int _i = 0; _i < 2; ++_i) \
        __builtin_amdgcn_global_load_lds((const unsigned*)((const char*)(gbase) + (voff)[_i]), (PG8_LAS unsigned*)(lds + (bufoff) + ldsw + _i * 8192), 16, 0, 0); } while (0)
#define PG8_LDA(dst, b, h) do { _Pragma("unroll") for (int m = 0; m < 4; ++m) _Pragma("unroll") for (int k = 0; k < 2; ++k) dst[m][k] = *(const PG8_LAS bf16x8*)(lds + PG8_SA(b, h) + aoff + m * 2048 + k * 1024); } while (0)
#define PG8_LDB(dst, b, h) do { _Pragma("unroll") for (int n = 0; n < 2; ++n) _Pragma("unroll") for (int k = 0; k < 2; ++k) dst[n][k] = *(const PG8_LAS bf16x8*)(lds + PG8_SB(b, h) + boff + n * 2048 + k * 1024); } while (0)
#define PG8_MMA(ai, bj, At, Bt) do { __builtin_amdgcn_s_setprio(1); _Pragma("unroll") for (int m = 0; m < 4; ++m) _Pragma("unroll") for (int n = 0; n < 2; ++n) _Pragma("unroll") for (int k = 0; k < 2; ++k) \
        acc[ai][bj][m][n] = __builtin_amdgcn_mfma_f32_16x16x32_bf16(Bt[n][k], At[m][k], acc[ai][bj][m][n], 0, 0, 0); __builtin_amdgcn_s_setprio(0); } while (0)
#define PG8_WAIT_V(n) asm volatile("s_waitcnt vmcnt(" #n ")" ::: "memory")
#define PG8_WAIT_L(n) asm volatile("s_waitcnt lgkmcnt(" #n ")" ::: "memory")
#define PG8_BAR __builtin_amdgcn_s_barrier()
#define PG8_SCHED __builtin_amdgcn_sched_barrier(0)
    Unit cur, nxt; int ui = 0;
    if (!S.next(0, cur)) return;
    f32x4 acc[2][2][4][2];
#pragma unroll
    for (int a = 0; a < 2; ++a)
#pragma unroll
        for (int b = 0; b < 2; ++b)
#pragma unroll
            for (int m = 0; m < 4; ++m)
#pragma unroll
                for (int n = 0; n < 2; ++n) acc[a][b][m][n] = (f32x4){0.f, 0.f, 0.f, 0.f};
    bf16x8 At[4][2], B0[2][2], B1[2][2];
    const char* cA = (const char*)g.A + (size_t)cur.pm * tstep + cur.koff; const char* cB = (const char*)g.Bt + (size_t)cur.pn * tstep + cur.koff;
    S.a_ready(cur);
    if constexpr (SP2) {
        PG8_STAGE(PG8_SB(0, 0), cB, voffB); PG8_STAGE(PG8_SB(0, 1), cB + hstep, voffB); PG8_STAGE(PG8_SA(0, 0), cA, voffA); PG8_STAGE(PG8_SA(0, 1), cA + hstep, voffA);
        if (wr == 1) PG8_BAR;
        PG8_WAIT_V(2); PG8_BAR;
        PG8_STAGE(PG8_SB(1, 0), cB + kstep, voffB); PG8_STAGE(PG8_SA(1, 0), cA + kstep, voffA); PG8_STAGE(PG8_SB(1, 1), cB + hstep + kstep, voffB);
        PG8_WAIT_V(6); PG8_BAR;
    } else {
        PG8_STAGE(PG8_SB(0, 0), cB, voffB); PG8_STAGE(PG8_SA(0, 0), cA, voffA); PG8_STAGE(PG8_SB(0, 1), cB + hstep, voffB); PG8_STAGE(PG8_SA(0, 1), cA + hstep, voffA);
        if (wr == 1) PG8_BAR;
        PG8_WAIT_V(4); PG8_BAR;
        PG8_STAGE(PG8_SB(1, 0), cB + kstep, voffB); PG8_STAGE(PG8_SA(1, 0), cA + kstep, voffA); PG8_STAGE(PG8_SB(1, 1), cB + hstep + kstep, voffB);
        PG8_WAIT_V(6); PG8_BAR;
    }
    for (;;) {
        const bool has_next = S.next(ui + 1, nxt);
        const char* nA = has_next ? (const char*)g.A + (size_t)nxt.pm * tstep + nxt.koff : cA; const char* nB = has_next ? (const char*)g.Bt + (size_t)nxt.pn * tstep + nxt.koff : cB;
        const int nt = cur.nt;
        for (int t = 0; t < nt; t += 2) {
            const bool last = (t == nt - 2);
            const char* a1 = cA + (size_t)(t + 1) * kstep;
            const char* a2 = last ? nA : cA + (size_t)(t + 2) * kstep; const char* b2 = last ? nB : cB + (size_t)(t + 2) * kstep;
            const char* a3 = a2 + kstep; const char* b3 = b2 + kstep;
            if (last && has_next) S.a_ready(nxt);
            if constexpr (SP2) {
            PG8_LDB(B0, 0, 0); PG8_LDB(B1, 0, 1); PG8_SCHED; PG8_LDA(At, 0, 0); PG8_STAGE(PG8_SA(1, 1), a1 + hstep, voffA);
            PG8_WAIT_V(8); PG8_WAIT_L(0); PG8_BAR; PG8_MMA(0, 0, At, B0); PG8_MMA(0, 1, At, B1); PG8_BAR; PG8_SCHED;
            PG8_LDA(At, 0, 1); PG8_STAGE(PG8_SB(0, 0), b2, voffB); PG8_STAGE(PG8_SB(0, 1), b2 + hstep, voffB); PG8_STAGE(PG8_SA(0, 0), a2, voffA);
            PG8_WAIT_V(8); PG8_WAIT_L(0); PG8_BAR; PG8_MMA(1, 0, At, B0); PG8_MMA(1, 1, At, B1); PG8_BAR; PG8_SCHED;
            PG8_LDB(B0, 1, 0); PG8_LDB(B1, 1, 1); PG8_SCHED; PG8_LDA(At, 1, 0); PG8_STAGE(PG8_SA(0, 1), a2 + hstep, voffA);
            PG8_WAIT_V(8); PG8_WAIT_L(0); PG8_BAR; PG8_MMA(0, 0, At, B0); PG8_MMA(0, 1, At, B1); PG8_BAR; PG8_SCHED;
            PG8_LDA(At, 1, 1); PG8_STAGE(PG8_SB(1, 0), b3, voffB); PG8_STAGE(PG8_SB(1, 1), b3 + hstep, voffB); PG8_STAGE(PG8_SA(1, 0), a3, voffA);
            PG8_WAIT_V(8); PG8_WAIT_L(0); PG8_BAR; PG8_MMA(1, 0, At, B0); PG8_MMA(1, 1, At, B1); PG8_BAR; PG8_SCHED;
            } else {
            PG8_LDB(B0, 0, 0); PG8_SCHED; PG8_LDA(At, 0, 0); PG8_STAGE(PG8_SA(1, 1), a1 + hstep, voffA);
            PG8_WAIT_L(8); PG8_BAR; PG8_WAIT_L(0); PG8_MMA(0, 0, At, B0); PG8_BAR; PG8_SCHED;
            PG8_LDB(B1, 0, 1); PG8_STAGE(PG8_SB(0, 0), b2, voffB);
            PG8_BAR; PG8_WAIT_L(0); PG8_MMA(0, 1, At, B1); PG8_BAR;
            PG8_LDA(At, 0, 1); PG8_STAGE(PG8_SA(0, 0), a2, voffA);
            PG8_BAR; PG8_WAIT_L(0); PG8_MMA(1, 0, At, B0); PG8_BAR; PG8_SCHED;
            PG8_STAGE(PG8_SB(0, 1), b2 + hstep, voffB);
            PG8_WAIT_V(6); PG8_BAR; PG8_MMA(1, 1, At, B1); PG8_BAR;
            PG8_LDB(B0, 1, 0); PG8_SCHED; PG8_LDA(At, 1, 0); PG8_STAGE(PG8_SA(0, 1), a2 + hstep, voffA);
            PG8_WAIT_L(8); PG8_BAR; PG8_WAIT_L(0); PG8_MMA(0, 0, At, B0); PG8_BAR; PG8_SCHED;
            PG8_LDB(B1, 1, 1); PG8_STAGE(PG8_SB(1, 0), b3, voffB);
            PG8_BAR; PG8_WAIT_L(0); PG8_MMA(0, 1, At, B1); PG8_BAR;
            PG8_LDA(At, 1, 1); PG8_STAGE(PG8_SA(1, 0), a3, voffA);
            PG8_BAR; PG8_WAIT_L(0); PG8_MMA(1, 0, At, B0); PG8_BAR; PG8_SCHED;
            PG8_STAGE(PG8_SB(1, 1), b3 + hstep, voffB);
            PG8_WAIT_V(6); PG8_BAR; PG8_MMA(1, 1, At, B1); PG8_BAR;
            }
        }
        if constexpr (ALIGN_EPI) { if (wr == 0) PG8_BAR; }
        if constexpr (!Epi::AFTER_DRAIN) { E(acc, cur, wr, wc, fr, fq); S.done(cur); }
        if (!has_next) break;
#pragma unroll
        for (int a = 0; a < 2; ++a)
#pragma unroll
            for (int b = 0; b < 2; ++b)
#pragma unroll
                for (int m = 0; m < 4; ++m)
#pragma unroll
                    for (int n = 0; n < 2; ++n) acc[a][b][m][n] = (f32x4){0.f, 0.f, 0.f, 0.f};
        cur = nxt; cA = nA; cB = nB; ++ui;
        if constexpr (ALIGN_EPI) { if (wr == 1) PG8_BAR; }
    }
    PG8_WAIT_V(0);
    if constexpr (!ALIGN_EPI) { if (wr == 0) PG8_BAR; }
    PG8_BAR;
    if constexpr (Epi::AFTER_DRAIN) { E.fused(acc, cur, wr, wc, fr, fq, lds, wid, lane); S.done(cur); }
#undef PG8_SA
#undef PG8_SB
#undef PG8_STAGE
#undef PG8_LDA
#undef PG8_LDB
#undef PG8_MMA
#undef PG8_WAIT_V
#undef PG8_WAIT_L
#undef PG8_BAR
#undef PG8_SCHED
}
}
#define LAS __attribute__((address_space(3)))
#define DI __device__ __forceinline__
typedef unsigned short bf16;
typedef short bf16x8 __attribute__((ext_vector_type(8)));
typedef short s16x4 __attribute__((ext_vector_type(4)));
typedef float f32x4 __attribute__((ext_vector_type(4)));
typedef float f32x16 __attribute__((ext_vector_type(16)));
typedef unsigned u32x4 __attribute__((ext_vector_type(4)));
typedef unsigned u32x2 __attribute__((ext_vector_type(2)));
using pg8::pk2;
constexpr int DM = 2048, TP = 8192, NB = 32, TS = 64, MR = 10240, NL = 4, PAST = 2048, DIN = 6144, DFF = 8192, GW = 512;
constexpr float EPS = 1e-6f;
constexpr size_t MiB = 1u << 20;
constexpr size_t WS_CTL = 0, CTL_ZERO_BYTES = 1 * MiB;
constexpr size_t WS_WIN = 2 * MiB, WS_WOUT = WS_WIN + 96 * MiB, WS_WUP = WS_WOUT + 32 * MiB, WS_WDN = WS_WUP + 128 * MiB;
constexpr size_t WS_POOLW = WS_WDN + 128 * MiB;
constexpr size_t WS_XB = WS_POOLW + 1 * MiB;
constexpr size_t WS_Z = WS_XB + 40 * MiB;
constexpr size_t WS_GF = WS_Z + 120 * MiB;
constexpr size_t WS_MIX = WS_GF + 20 * MiB;
constexpr size_t WS_U = WS_MIX + 40 * MiB;
constexpr size_t WS_DS = WS_U + 160 * MiB;
constexpr size_t WS_HDEC = WS_DS + 64 * MiB;
constexpr size_t WS_SSQ = WS_HDEC + 1 * MiB;
constexpr size_t WS_SLAB = WS_SSQ + 12 * MiB;
constexpr size_t WS_LB = WS_SLAB + 64 * MiB;
constexpr size_t WS_END = WS_LB + 1 * MiB;
constexpr int CW_BAR = 4096, CW_Q = 8192, CW_DEP = 16384;
constexpr size_t O_Y = 0, O_RETP = 20971520, O_RETS = O_RETP + 262144, O_SBKP = O_RETS + 8388608, O_SBVP = O_SBKP + 16777216, O_SBKS = O_SBVP + 16777216,
                 O_SBVS = O_SBKS + 4194304, O_POOLP = O_SBVS + 4194304, O_POOLS = O_POOLP + 30720, O_HGP = O_POOLS + 983040, O_HGS = O_HGP + 262144, O_END = O_HGS + 8388608;
constexpr int LDS_CTL_OFF = 131072, LDS_BYTES = 147456;

DI float bflo(unsigned w) { return __uint_as_float(w << 16); }
DI float bfhi(unsigned w) { return __uint_as_float(w & 0xffff0000u); }
DI float fexp2(float x) { return __builtin_amdgcn_exp2f(x); }
DI float flog2(float x) { return __builtin_amdgcn_logf(x); }
DI float fexp(float x) { return __builtin_amdgcn_exp2f(x * 1.4426950408889634f); }
DI float sigmoidf_(float x) { return __builtin_amdgcn_rcpf(1.0f + fexp(-x)); }
#define MFMA32(a, b, c) __builtin_amdgcn_mfma_f32_32x32x16_bf16((a), (b), (c), 0, 0, 0)
DI int crow(int reg, int h) { return (reg & 3) + 8 * (reg >> 2) + 4 * h; }
constexpr unsigned RS = 272, TRS = 320;
DI bf16x8 ld_row(LAS const unsigned char* base, unsigned row, unsigned s, unsigned h) { return *(LAS const bf16x8*)(base + RS * row + 32u * s + 16u * h); }
DI s16x4 tr4(LAS const unsigned char* base, unsigned row0, unsigned c, unsigned lane) {
    const unsigned blk = (lane >> 4) & 1u, q = (lane & 15u) >> 2, p = lane & 3u;
    return __builtin_amdgcn_ds_read_tr16_b64_v4i16((LAS s16x4*)(base + TRS * (row0 + q) + 64u * c + 32u * blk + 8u * p));
}
DI bf16x8 tr8(LAS const unsigned char* base, unsigned rowA, unsigned rowB, unsigned c, unsigned lane) {
    const s16x4 lo = tr4(base, rowA, c, lane), hi = tr4(base, rowB, c, lane);
    return __builtin_shufflevector(lo, hi, 0, 1, 2, 3, 4, 5, 6, 7);
}
DI bf16x8 pack8(float a0, float a1, float a2, float a3, float a4, float a5, float a6, float a7) {
    u32x4 p; p.x = pk2(a0, a1); p.y = pk2(a2, a3); p.z = pk2(a4, a5); p.w = pk2(a6, a7); return __builtin_bit_cast(bf16x8, p);
}
DI f32x16 zero16() { f32x16 z; for (int i = 0; i < 16; ++i) z[i] = 0.f; return z; }
DI int wq_claim(unsigned* ctr) { return (threadIdx.x == 0) ? (int)__hip_atomic_fetch_add(ctr, 1u, __ATOMIC_RELAXED, __HIP_MEMORY_SCOPE_AGENT) : 0; }
DI int wq_next(unsigned* ctr, volatile LAS int* slot, int& pre, int& par, const int base = 0) {
    if (threadIdx.x == 0) slot[par] = pre;
    __syncthreads();
    const int it = slot[par];
    par ^= 1;
    pre = base + wq_claim(ctr);
    return it;
}
DI void st_wt(float* p, float v) { __hip_atomic_store((unsigned*)p, __float_as_uint(v), __ATOMIC_RELAXED, __HIP_MEMORY_SCOPE_AGENT); }
DI float ld_wt(const float* p) { return __uint_as_float(__hip_atomic_load((const unsigned*)p, __ATOMIC_RELAXED, __HIP_MEMORY_SCOPE_AGENT)); }
DI void st_wt32(unsigned* p, unsigned v) { __hip_atomic_store(p, v, __ATOMIC_RELAXED, __HIP_MEMORY_SCOPE_AGENT); }
DI unsigned ld_wt32(const unsigned* p) { return __hip_atomic_load(p, __ATOMIC_RELAXED, __HIP_MEMORY_SCOPE_AGENT); }
DI unsigned long long ld_wt64(const unsigned long long* p) { return __hip_atomic_load(p, __ATOMIC_RELAXED, __HIP_MEMORY_SCOPE_AGENT); }
DI void dep_publish(unsigned* ctr) {
    asm volatile("s_waitcnt vmcnt(0)" ::: "memory");
    __syncthreads();
    if (threadIdx.x == 0) __hip_atomic_fetch_add(ctr, 1u, __ATOMIC_RELAXED, __HIP_MEMORY_SCOPE_AGENT);
}
DI void dep_wait(unsigned* ctr, const unsigned need, unsigned* tmo) {
    if (threadIdx.x == 0) {
        unsigned sp = 0;
        while (__hip_atomic_load(ctr, __ATOMIC_RELAXED, __HIP_MEMORY_SCOPE_AGENT) < need) {
            __builtin_amdgcn_s_sleep(2);
            if ((++sp & 1023u) == 0u) { if (__hip_atomic_load(tmo, __ATOMIC_RELAXED, __HIP_MEMORY_SCOPE_AGENT) != 0u) break; if (sp > (1u << 22)) { __hip_atomic_fetch_add(tmo, 1u, __ATOMIC_RELAXED, __HIP_MEMORY_SCOPE_AGENT); break; } }
        }
        __builtin_amdgcn_fence(__ATOMIC_ACQUIRE, "agent");
        asm volatile("s_waitcnt vmcnt(0)" ::: "memory");
    }
    __syncthreads();
}
DI void dep_wait_sc1(unsigned* ctr, const unsigned need, unsigned* tmo) {
    if (threadIdx.x == 0) {
        unsigned sp = 0;
        while (__hip_atomic_load(ctr, __ATOMIC_RELAXED, __HIP_MEMORY_SCOPE_AGENT) < need) {
            __builtin_amdgcn_s_sleep(2);
            if ((++sp & 1023u) == 0u) { if (__hip_atomic_load(tmo, __ATOMIC_RELAXED, __HIP_MEMORY_SCOPE_AGENT) != 0u) break; if (sp > (1u << 22)) { __hip_atomic_fetch_add(tmo, 1u, __ATOMIC_RELAXED, __HIP_MEMORY_SCOPE_AGENT); break; } }
        }
    }
    __builtin_amdgcn_fence(__ATOMIC_ACQUIRE, "wavefront");
    __syncthreads();
}
#define XB_TMO      128
#define XB_XCNT(j)  (256  + 64 * (j))
#define XB_XSUB(j)  (1280 + 64 * (j))
#define XB_XGEN(j)  (2304 + 64 * (j))
#define XB_TOP      3328
#define XB_TOPGEN   3392
#define XCD_BAR_WORDS 3456
#define XB_SPIN_CAP (1u << 18)

__device__ __forceinline__ unsigned xb_ld(unsigned* p)              { return __hip_atomic_load(p, __ATOMIC_RELAXED, __HIP_MEMORY_SCOPE_AGENT); }
__device__ __forceinline__ unsigned xb_add(unsigned* p, unsigned v) { return __hip_atomic_fetch_add(p, v, __ATOMIC_RELAXED, __HIP_MEMORY_SCOPE_AGENT); }
__device__ __forceinline__ unsigned xb_xcc_id() { return (unsigned)__builtin_amdgcn_s_getreg((3 << 11) | 20) & 0xFu; }
#define XB_SPIN(cond, bar) do { unsigned _sp = 0; while (cond) { __builtin_amdgcn_s_sleep(1); \
    if ((++_sp & 255u) == 0u) { if (xb_ld(&(bar)[XB_TMO])) break; if (_sp > XB_SPIN_CAP) { atomicAdd(&(bar)[XB_TMO], 1u); break; } } } } while (0)

struct XcdBarrier {
    unsigned* bar; unsigned x;
    volatile LAS unsigned* st;
};

__device__ __forceinline__ XcdBarrier xcd_barrier_post(unsigned* bar, volatile LAS unsigned* st) {
    XcdBarrier b; b.bar = bar; b.x = xb_xcc_id(); b.st = st;
    if (threadIdx.x == 0) (void)xb_add(&bar[XB_XCNT(b.x)], 1u);
    return b;
}
__device__ __forceinline__ void xcd_barrier_complete(unsigned* bar, unsigned x, unsigned& nloc, unsigned& nx) {
    const unsigned G = gridDim.x * gridDim.y * gridDim.z;
    unsigned sum, cnt, mine, sp = 0u;
    for (;;) {
        sum = 0u; cnt = 0u; mine = 0u;
#pragma unroll
        for (unsigned j = 0; j < 16; ++j) { const unsigned c = xb_ld(&bar[XB_XCNT(j)]); sum += c; cnt += (c > 0u) ? 1u : 0u; mine = (j == x) ? c : mine; }
        if (sum == G) break;
        __builtin_amdgcn_s_sleep(1);
        if ((++sp & 255u) == 0u) { if (xb_ld(&bar[XB_TMO])) break; if (sp > XB_SPIN_CAP) { atomicAdd(&bar[XB_TMO], 1u); break; } }
    }
    nloc = mine > 0u ? mine : 1u; nx = cnt > 0u ? cnt : 1u;
}

__device__ __forceinline__ void xcd_barrier(const XcdBarrier& b) {
    asm volatile("s_waitcnt vmcnt(0)" ::: "memory");
    __syncthreads();
    if (threadIdx.x == 0) {
        unsigned* bar = b.bar;
        __builtin_amdgcn_s_waitcnt(0);
        unsigned nloc = b.st[0], nx = b.st[1];
        if (nloc == 0u) { xcd_barrier_complete(bar, b.x, nloc, nx); b.st[0] = nloc; b.st[1] = nx; }
        const unsigned old = xb_add(&bar[XB_XSUB(b.x)], 1u);
        const unsigned gen = old / nloc;
        if (old + 1u == (gen + 1u) * nloc) {
            __builtin_amdgcn_fence(__ATOMIC_RELEASE, "agent");
            asm volatile("s_waitcnt vmcnt(0)" ::: "memory");
            const unsigned og = xb_add(&bar[XB_TOP], 1u);
            const unsigned tg = og / nx;
            if (og + 1u == (tg + 1u) * nx) xb_add(&bar[XB_TOPGEN], 1u);
            else XB_SPIN(xb_ld(&bar[XB_TOPGEN]) == tg, bar);
            __builtin_amdgcn_fence(__ATOMIC_ACQUIRE, "agent");
            xb_add(&bar[XB_XGEN(b.x)], 1u);
            asm volatile("s_waitcnt vmcnt(0)" ::: "memory");
        } else {
            XB_SPIN(xb_ld(&bar[XB_XGEN(b.x)]) == gen, bar);
            __builtin_amdgcn_fence(__ATOMIC_ACQUIRE, "agent");
            asm volatile("s_waitcnt vmcnt(0)" ::: "memory");
        }
    }
    __syncthreads();
}
struct TrItem { const float* src; bf16* dst; int N, K; f32x4 gq[4]; float cs; };
DI void tr_setup(TrItem& t, const float* W, const int K, const int N, bf16* WT, const float* kgain, const int cs_lo1, const int cs_hi1, const float cs1, const int cs_lo2, const int cs_hi2, const float cs2,
                 const int item, const int lane) {
    const int nblk = N / 64, kb = item / nblk, nb = item % nblk, k0 = 64 * kb, n0 = 64 * nb;
    const int n4 = lane & 15, kq = lane >> 4, ncol = n0 + 4 * n4;
    const float cs = (ncol >= cs_lo1 && ncol < cs_hi1) ? cs1 : ((ncol >= cs_lo2 && ncol < cs_hi2) ? cs2 : 1.0f);
    t.src = W + (size_t)(k0 + 8 * kq) * N + ncol; t.dst = WT + (size_t)ncol * K + k0 + 8 * kq; t.N = N; t.K = K;
    t.cs = cs;
#pragma unroll
    for (int q = 0; q < 4; ++q) t.gq[q] = *(const f32x4*)(kgain + k0 + 8 * kq + 4 * (q & 1) + 32 * (q >> 1));
}
DI void tr_load(const TrItem& t, f32x4 (&v)[16]) {
#pragma unroll
    for (int i = 0; i < 16; ++i) v[i] = __builtin_nontemporal_load((const f32x4*)(t.src + (size_t)((i & 7) + 32 * (i >> 3)) * t.N));
}
DI void tr_store(const TrItem& t, const f32x4 (&v)[16]) {
    float gk[16];
#pragma unroll
    for (int i = 0; i < 16; ++i) gk[i] = t.gq[i >> 2][i & 3] * t.cs;
#pragma unroll
    for (int e = 0; e < 4; ++e) {
        bf16* dst = t.dst + (size_t)e * t.K;
        *(bf16x8*)(dst) = pack8(v[0][e] * gk[0], v[1][e] * gk[1], v[2][e] * gk[2], v[3][e] * gk[3], v[4][e] * gk[4], v[5][e] * gk[5], v[6][e] * gk[6], v[7][e] * gk[7]);
        *(bf16x8*)(dst + 32) = pack8(v[8][e] * gk[8], v[9][e] * gk[9], v[10][e] * gk[10], v[11][e] * gk[11], v[12][e] * gk[12], v[13][e] * gk[13], v[14][e] * gk[14], v[15][e] * gk[15]);
    }
}
constexpr int CV_IN = (DM / 64) * (DIN / 64), CV_OUT = (DM / 64) * (DM / 64), CV_UP = (DM / 64) * (DFF / 64), CV_DN = (DFF / 64) * (DM / 64);
DI void conv_setup(TrItem& t, const float* w_in, const float* w_out, const float* w_up, const float* w_down, const float* norm1_g, const float* norm2_g, const float* ones, bf16* WinT, bf16* WoutT, bf16* WupT, bf16* WdnT,
                   const int l, const int rr, const int lane) {
    const int which = (rr >= CV_IN) + (rr >= CV_IN + CV_OUT) + (rr >= CV_IN + CV_OUT + CV_UP);
    const int item = rr - (which >= 1 ? CV_IN : 0) - (which >= 2 ? CV_OUT : 0) - (which >= 3 ? CV_UP : 0);
    const float* W = which == 0 ? w_in + (size_t)l * DM * DIN : which == 1 ? w_out + (size_t)l * DM * DM : which == 2 ? w_up + (size_t)l * DM * DFF : w_down + (size_t)l * DFF * DM;
    bf16* WT = which == 0 ? WinT + (size_t)l * DIN * DM : which == 1 ? WoutT + (size_t)l * DM * DM : which == 2 ? WupT + (size_t)l * DFF * DM : WdnT + (size_t)l * DM * DFF;
    const int K = which == 3 ? DFF : DM, N = which == 0 ? DIN : which == 2 ? DFF : DM;
    const float* kg = which == 0 ? norm1_g + l * DM : which == 2 ? norm2_g + l * DM : ones;
    const int lo1 = which == 0 ? 512 : 0, hi1 = which == 0 ? 1024 : 0, lo2 = which == 0 ? 2048 : 0, hi2 = which == 0 ? 2560 : 0;
    tr_setup(t, W, K, N, WT, kg, lo1, hi1, 0.08838834764831845f, lo2, hi2, 0.08838834764831845f * 1.4426950408889634f, item, lane);
}
DI void conv_wave_pair(const float* w_in, const float* w_out, const float* w_up, const float* w_down, const float* norm1_g, const float* norm2_g, const float* ones, bf16* WinT, bf16* WoutT, bf16* WupT, bf16* WdnT,
                       const int l0, const int r0, const int l1, const int r1, const int lane) {
    TrItem t0, t1; f32x4 v0[16], v1[16];
    conv_setup(t0, w_in, w_out, w_up, w_down, norm1_g, norm2_g, ones, WinT, WoutT, WupT, WdnT, l0, r0, lane); tr_load(t0, v0);
    conv_setup(t1, w_in, w_out, w_up, w_down, norm1_g, norm2_g, ones, WinT, WoutT, WupT, WdnT, l1, r1, lane); tr_load(t1, v1);
    tr_store(t0, v0); tr_store(t1, v1);
}
struct ConvCtx { const float* w_in; const float* w_out; const float* w_up; const float* w_down; const float* norm1_g; const float* norm2_g; const float* ones; bf16* WinT; bf16* WoutT; bf16* WupT; bf16* WdnT; };
DI bool conv_list_setup(TrItem& t, const ConvCtx& c, const int l, const int wi_in, const int lane) {
    const bool on = (wi_in >= 0) && ((wi_in < CV_OUT + CV_UP + CV_DN) || (l + 1 < NL));
    const int wi = on ? wi_in : 0;
    const bool nextl = wi >= CV_OUT + CV_UP + CV_DN;
    conv_setup(t, c.w_in, c.w_out, c.w_up, c.w_down, c.norm1_g, c.norm2_g, c.ones, c.WinT, c.WoutT, c.WupT, c.WdnT, nextl ? l + 1 : l, nextl ? wi - (CV_OUT + CV_UP + CV_DN) : CV_IN + wi, lane);
    return on;
}
struct SbArgs {
    const bf16* zq; const bf16* zk; const bf16* zv;
    const float* kc; const float* vc;
    int nf32, t_hi, qpos0, nqw;
    bf16* mixo;
    float* ok; int ovd, own_lo;
};
typedef float f32x2 __attribute__((ext_vector_type(2)));
DI void sb_sub(LAS const unsigned char* Kb, LAS const unsigned char* Vb, const bf16x8 (&qf)[8], f32x16 (&O)[4], float& R, const int kt, const int kp_base, const int qp,
               const bool needmask, const int r, const int h, const int lane) {
    f32x16 X = zero16();
#pragma unroll
    for (int s = 0; s < 8; ++s) X = MFMA32(ld_row(Kb, 32 * kt + r, s, h), qf[s], X);
    f32x2 E[8], F[8];
#pragma unroll
    for (int p = 0; p < 2; ++p)
#pragma unroll
        for (int jj = 0; jj < 4; ++jj) {
            f32x2 u2 = {X[8 * p + jj], X[8 * p + 4 + jj]};
            u2 = __builtin_elementwise_min(u2, (f32x2){64.f, 64.f});
            f32x2 e2; e2.x = fexp2(u2.x); e2.y = fexp2(u2.y);
            const f32x2 d2 = e2 + 1.0f;
            f32x2 f2; f2.x = __builtin_amdgcn_rcpf(d2.x); f2.y = __builtin_amdgcn_rcpf(d2.y);
            E[4 * p + jj] = e2; F[4 * p + jj] = f2;
        }
    if (needmask) {
#pragma unroll
        for (int p = 0; p < 2; ++p)
#pragma unroll
            for (int jj = 0; jj < 4; ++jj) {
                const int kpa = kp_base + 4 * h + jj + 8 * (2 * p), kpb = kpa + 8;
                const bool va = kpa < qp, vb = kpb < qp;
                E[4 * p + jj].x = va ? E[4 * p + jj].x : 0.f; F[4 * p + jj].x = va ? F[4 * p + jj].x : 1.f;
                E[4 * p + jj].y = vb ? E[4 * p + jj].y : 0.f; F[4 * p + jj].y = vb ? F[4 * p + jj].y : 1.f;
            }
    }
    float gp[4], pp[4], pt[4], T[4];
#pragma unroll
    for (int p = 0; p < 2; ++p) { const f32x2 g2 = (F[4 * p] * F[4 * p + 1]) * (F[4 * p + 2] * F[4 * p + 3]); gp[2 * p] = g2.x; gp[2 * p + 1] = g2.y; }
#pragma unroll
    for (int g = 0; g < 4; ++g) { const unsigned x = __float_as_uint(gp[g]); const auto sw = __builtin_amdgcn_permlane32_swap(x, x, false, false);
        const float a0 = __uint_as_float(sw[0]), a1 = __uint_as_float(sw[1]);
        pp[g] = a0 * a1; pt[g] = (h == 0) ? a1 : 1.0f; }
    T[3] = 1.0f; T[2] = pp[3]; T[1] = T[2] * pp[2]; T[0] = T[1] * pp[1];
    float P[16];
#pragma unroll
    for (int p = 0; p < 2; ++p) {
        f32x2 c2 = {R * T[2 * p] * pt[2 * p], R * T[2 * p + 1] * pt[2 * p + 1]};
#pragma unroll
        for (int jj = 3; jj >= 0; --jj) { c2 = c2 * F[4 * p + jj]; const f32x2 a2 = E[4 * p + jj] * c2; P[8 * p + jj] = a2.x; P[8 * p + 4 + jj] = a2.y; }
    }
    R = R * (T[0] * pp[0]);
    const bf16x8 pa0 = pack8(P[0], P[1], P[2], P[3], P[4], P[5], P[6], P[7]), pa1 = pack8(P[8], P[9], P[10], P[11], P[12], P[13], P[14], P[15]);
#pragma unroll
    for (int ei = 0; ei < 4; ++ei) {
        const bf16x8 vb0 = tr8(Vb, 32 * kt + 4 * h, 32 * kt + 8 + 4 * h, ei, lane);
        O[ei] = MFMA32(pa0, vb0, O[ei]);
        const bf16x8 vb1 = tr8(Vb, 32 * kt + 16 + 4 * h, 32 * kt + 24 + 4 * h, ei, lane);
        O[ei] = MFMA32(pa1, vb1, O[ei]);
    }
}
constexpr int SB_V0 = 64 * 272, SB_BUF = 64 * 272 + 64 * 320;
constexpr int SB_CVN = 4;
DI void sb_item(LAS unsigned char* lds, const SbArgs& a, const ConvCtx& cvx, const int cv_l, const int cv_base, const int tid_in) {
    int tid = tid_in; asm volatile("" : "+v"(tid));
    const int lane = tid & 63, w = __builtin_amdgcn_readfirstlane(tid >> 6), r = lane & 31, h = lane >> 5;
    const bool active = w < a.nqw;
    u32x4 st[4];
#define SB_LOAD(j) do { if ((j) < a.nf32) { \
        _Pragma("unroll") for (int i_ = 0; i_ < 2; ++i_) { const int n_ = tid + 512 * i_, row_ = n_ >> 5, c4_ = n_ & 31; const size_t o_ = (size_t)(32 * (j) + row_) * 512 + 4 * c4_; \
            st[i_] = *(const u32x4*)(a.kc + o_); st[2 + i_] = *(const u32x4*)(a.vc + o_); } \
    } else { const int jj_ = (j) - a.nf32; \
        _Pragma("unroll") for (int i_ = 0; i_ < 2; ++i_) { const int n_ = tid + 512 * i_, row_ = n_ >> 4, ch_ = n_ & 15; const size_t o_ = (size_t)(64 * jj_ + row_) * 6144 + 8 * ch_; \
            st[i_] = *(const u32x4*)(a.zk + o_); st[2 + i_] = *(const u32x4*)(a.zv + o_); } } } while (0)
#define SB_WRITE(j, Kd, Vd) do { if ((j) < a.nf32) { \
        _Pragma("unroll") for (int i_ = 0; i_ < 2; ++i_) { const int n_ = tid + 512 * i_, row_ = n_ >> 5, c4_ = n_ & 31; const unsigned ok_ = RS * row_ + 8u * c4_, ov_ = TRS * row_ + 8u * c4_; \
            u32x2 kk_, vv_; kk_.x = pk2(__uint_as_float(st[i_].x), __uint_as_float(st[i_].y)); kk_.y = pk2(__uint_as_float(st[i_].z), __uint_as_float(st[i_].w)); \
            vv_.x = pk2(__uint_as_float(st[2 + i_].x), __uint_as_float(st[2 + i_].y)); vv_.y = pk2(__uint_as_float(st[2 + i_].z), __uint_as_float(st[2 + i_].w)); \
            *(LAS u32x2*)((Kd) + ok_) = kk_; *(LAS u32x2*)((Vd) + ov_) = vv_; } \
    } else { const bool own_ = (j) >= a.own_lo; const int jw_ = (j) - a.nf32; \
        _Pragma("unroll") for (int i_ = 0; i_ < 2; ++i_) { const int n_ = tid + 512 * i_, row_ = n_ >> 4, ch_ = n_ & 15; \
            *(LAS u32x4*)((Kd) + RS * row_ + 16u * ch_) = st[i_]; *(LAS u32x4*)((Vd) + TRS * row_ + 16u * ch_) = st[2 + i_]; \
            if (own_) { const unsigned oo_ = (unsigned)((64 * jw_ + row_) * 512 + 8 * ch_) * 4u; const u32x4 k_ = st[i_], v_ = st[2 + i_]; char* pk_ = (char*)a.ok; char* pv_ = (char*)(a.ok + a.ovd); \
                *(f32x4*)(pk_ + oo_) = (f32x4){bflo(k_.x), bfhi(k_.x), bflo(k_.y), bfhi(k_.y)}; *(f32x4*)(pk_ + oo_ + 16u) = (f32x4){bflo(k_.z), bfhi(k_.z), bflo(k_.w), bfhi(k_.w)}; \
                *(f32x4*)(pv_ + oo_) = (f32x4){bflo(v_.x), bfhi(v_.x), bflo(v_.y), bfhi(v_.y)}; *(f32x4*)(pv_ + oo_ + 16u) = (f32x4){bflo(v_.z), bfhi(v_.z), bflo(v_.w), bfhi(v_.w)}; } } } } while (0)
#define SB_WALK(BODY, FLAG) do { int cur = 0; \
    for (int j = a.t_hi; j >= 0; --j) { \
        LAS unsigned char* Kb = lds + cur * SB_BUF; LAS unsigned char* Vb = Kb + SB_V0; \
        if (j > 0) SB_LOAD(j - 1); \
        BODY \
        if (j > 0) SB_WRITE(j - 1, lds + (cur ^ 1) * SB_BUF, lds + (cur ^ 1) * SB_BUF + SB_V0); \
        if (lane == 0) dflag[8 * cur + w] = (FLAG) ? 1 : 0; \
        __syncthreads(); \
        {   int alld = 1; \
            _Pragma("unroll") for (int i = 0; i < 8; ++i) alld &= dflag[8 * cur + i]; \
            if (alld) break; } \
        cur ^= 1; \
    } } while (0)
    volatile LAS int* dflag = (volatile LAS int*)(lds + 2 * SB_BUF);
    if (active) {
        bf16x8 qf[8];
        {   const bf16* qp_ = a.zq + (size_t)(32 * w + r) * 6144 + 8 * h;
#pragma unroll
            for (int s = 0; s < 8; ++s) qf[s] = *(const bf16x8*)(qp_ + 16 * s); }
        f32x16 O[4]; O[0] = zero16(); O[1] = zero16(); O[2] = zero16(); O[3] = zero16();
        float R = 1.0f;
        const int qmin = a.qpos0 + 32 * w, qmax = qmin + 31, qp = qmin + r;
        SB_LOAD(a.t_hi); SB_WRITE(a.t_hi, lds, lds + SB_V0);
        __syncthreads();
        SB_WALK({
            const bool f32t = j < a.nf32;
            const int kp0 = f32t ? 32 * j : 32 * a.nf32 + 64 * (j - a.nf32);
            const int nk = f32t ? 32 : 64;
            if (kp0 < qmax) {
                const bool needmask = (kp0 + nk - 1 >= qmin);
                if (!f32t) sb_sub(Kb, Vb, qf, O, R, 1, kp0 + 32, qp, needmask, r, h, lane);
                sb_sub(Kb, Vb, qf, O, R, 0, kp0, qp, needmask, r, h, lane);
            } }, (__ballot(R != 0.0f) == 0ull));
        LAS unsigned char* ob = lds + w * 8192;
#pragma unroll
        for (int ei = 0; ei < 4; ++ei)
#pragma unroll
            for (int i = 0; i < 16; ++i) *(LAS unsigned short*)(ob + crow(i, h) * 256 + (32 * ei + r) * 2) = (unsigned short)(pk2(O[ei][i], 0.f) & 0xffffu);
#pragma unroll
        for (int i = 0; i < 8; ++i) { const int n = lane + 64 * i, row = n >> 4, ch = n & 15;
            const u32x4 v = *(LAS const u32x4*)(ob + row * 256 + ch * 16);
            *(u32x4*)(a.mixo + (size_t)(32 * w + row) * 2048 + 8 * ch) = v; }
    } else {
        TrItem tA; f32x4 vA[16]; bool onA = false;
        const int cvw = cv_base + (w - a.nqw) * SB_CVN;
        int ci = (cv_base >= 0) ? 0 : SB_CVN, cs = ci;
        for (int i = 0; i < 16; ++i) vA[i] = (f32x4){0.f, 0.f, 0.f, 0.f};
        tA.src = nullptr; tA.dst = nullptr; tA.N = 0; tA.K = 0; tA.cs = 0.f;
        for (int q = 0; q < 4; ++q) tA.gq[q] = (f32x4){0.f, 0.f, 0.f, 0.f};
        SB_LOAD(a.t_hi); SB_WRITE(a.t_hi, lds, lds + SB_V0);
        __syncthreads();
        SB_WALK({
            if (cs < ci) { if (onA) tr_store(tA, vA); ++cs; }
            if (ci < SB_CVN) { onA = conv_list_setup(tA, cvx, cv_l, cvw + ci, lane); tr_load(tA, vA); ++ci; } }, true);
        while (cs < SB_CVN) {
            if (cs == ci) { onA = conv_list_setup(tA, cvx, cv_l, cvw + ci, lane); tr_load(tA, vA); ++ci; }
            if (onA) tr_store(tA, vA);
            ++cs; }
    }
#undef SB_WALK
#undef SB_LOAD
#undef SB_WRITE
}
constexpr int LA_QT = 0, LA_QI = 17408, LA_KT = 34816, LA_KS = 52224, LA_VV = 72704, LA_G = 93184;
struct LaArgs {
    const bf16* z;
    int h, pos0, mode, prompt;
    const float* Sprev;
    const bf16* SpT;
    bf16* dSout;
    float* Sout;
    float* hdec;
    const float* ng;
    const float* lbsrc;
    int layer;
    bf16* mixo;
    unsigned* pub_prev;
    unsigned* dep_done; unsigned* dep_need; unsigned* tmo;
    int cv_wi;
};
template <int MIXER, int MODE>
DI void la_item(LAS unsigned char* lds, const LaArgs& a, const ConvCtx& cvx, const int tid_in) {
    int tid = tid_in; asm volatile("" : "+v"(tid));
    const int lane = tid & 63, w = __builtin_amdgcn_readfirstlane(tid >> 6), r = lane & 31, h = lane >> 5;
    LAS unsigned char* QT = lds + LA_QT; LAS unsigned char* QI = lds + LA_QI; LAS unsigned char* KT = lds + LA_KT; LAS unsigned char* KS = lds + LA_KS; LAS unsigned char* VV = lds + LA_VV;
    LAS float* G = (LAS float*)(lds + LA_G);
    bool pubdone = false;
    if (MODE == 2 && a.dep_need) { if (a.pub_prev) { dep_publish(a.pub_prev); pubdone = true; } dep_wait_sc1(a.dep_need, 16u, a.tmo); }
    float sv[8][8]; unsigned long long svq[8][2]; u32x4 gw0 = {0u, 0u, 0u, 0u}, gw1 = {0u, 0u, 0u, 0u}; f32x4 ngv[4];
    if (MODE == 2) {
        const unsigned long long* sp0 = (const unsigned long long*)(a.SpT + (32 * (w & 3) + r) * 128 + 8 * h);
#pragma unroll
        for (int s = 0; s < 8; ++s) { svq[s][0] = ld_wt64(sp0 + 4 * s); svq[s][1] = ld_wt64(sp0 + 4 * s + 1); }
    }
    if (MODE & 2) {
        const bf16* gz = a.z + (size_t)(tid >> 3) * 6144 + (MIXER == 0 ? 3 * 512 : 11 * 512) + a.h * 128 + 16 * (tid & 7);
        gw0 = *(const u32x4*)(gz); gw1 = *(const u32x4*)(gz + 8);
#pragma unroll
        for (int q4 = 0; q4 < 4; ++q4) ngv[q4] = *(const f32x4*)(a.ng + 16 * (tid & 7) + 4 * q4);
    }
    float decay_s = 1.f;
    if (MIXER == 0) {
        const float lg = flog2(1.0f - fexp2(-5.0f - (float)a.h));
        decay_s = fexp2(64.0f * lg);
        const int m = tid >> 3, j0 = 8 * (tid & 7);
        const bf16* zr = a.z + (size_t)m * 6144 + a.h * 128;
        const u32x4 q1 = *(const u32x4*)(zr + j0), q2 = *(const u32x4*)(zr + 64 + j0), k1 = *(const u32x4*)(zr + 512 + j0), k2 = *(const u32x4*)(zr + 512 + 64 + j0);
        const u32x4 v0 = *(const u32x4*)(zr + 1024 + 2 * j0), v1 = *(const u32x4*)(zr + 1024 + 2 * j0 + 8);
        const float posf = (float)(a.pos0 + m);
        const float sqt = fexp2((float)(m - 32) * lg), sqi = fexp2((float)(m + 1) * lg), skt = fexp2((float)(32 - m) * lg), sks = fexp2((float)(63 - m) * lg);
        float qa[8], qb[8], ka[8], kb[8];
#pragma unroll
        for (int jj = 0; jj < 8; ++jj) {
            const unsigned wq1 = q1[jj >> 1], wq2 = q2[jj >> 1], wk1 = k1[jj >> 1], wk2 = k2[jj >> 1];
            const float x1 = (jj & 1) ? bfhi(wq1) : bflo(wq1), x2 = (jj & 1) ? bfhi(wq2) : bflo(wq2), y1 = (jj & 1) ? bfhi(wk1) : bflo(wk1), y2 = (jj & 1) ? bfhi(wk2) : bflo(wk2);
            const float inv = fexp2(-(float)(j0 + jj) * (13.287712379549449f / 64.0f));
            const float ang = posf * inv;
            const float fr = __builtin_amdgcn_fractf(ang * 0.15915494309189535f);
            const float sn = __builtin_amdgcn_sinf(fr), cs = __builtin_amdgcn_cosf(fr);
            qa[jj] = x1 * cs - x2 * sn; qb[jj] = x1 * sn + x2 * cs; ka[jj] = y1 * cs - y2 * sn; kb[jj] = y1 * sn + y2 * cs;
        }
        const unsigned c1 = (unsigned)(tid & 7), c2 = c1 + 8u;
#define LA_ST(T, ST, ch, AR, sc) do { u32x4 p_; p_[0] = pk2(AR[0] * (sc), AR[1] * (sc)); p_[1] = pk2(AR[2] * (sc), AR[3] * (sc)); p_[2] = pk2(AR[4] * (sc), AR[5] * (sc)); p_[3] = pk2(AR[6] * (sc), AR[7] * (sc)); \
            *(LAS u32x4*)((T) + (ST) * m + 16u * (ch)) = p_; } while (0)
        if (MODE & 2) { LA_ST(QT, RS, c1, qa, sqt); LA_ST(QT, RS, c2, qb, sqt); LA_ST(QI, RS, c1, qa, sqi); LA_ST(QI, RS, c2, qb, sqi); LA_ST(KT, RS, c1, ka, skt); LA_ST(KT, RS, c2, kb, skt); }
        if (MODE & 1) { LA_ST(KS, TRS, c1, ka, sks); LA_ST(KS, TRS, c2, kb, sks); }
        *(LAS u32x4*)(VV + TRS * m + 32u * c1) = v0; *(LAS u32x4*)(VV + TRS * m + 32u * c1 + 16u) = v1;
    } else {
        const int m = tid >> 3, d0 = 16 * (tid & 7);
        const bf16* zr = a.z + (size_t)m * 6144 + a.h * 128 + d0;
        const u32x4 fw0 = *(const u32x4*)(zr + 9 * 512), fw1 = *(const u32x4*)(zr + 9 * 512 + 8);
        float kk[16];
#pragma unroll
        for (int q4 = 0; q4 < 4; ++q4) {
            f32x4 lfv;
#pragma unroll
            for (int jj = 0; jj < 4; ++jj) {
                const int c = a.h * 128 + d0 + 4 * q4 + jj;
                const float lb = a.lbsrc[c];
                const unsigned wf = (q4 < 2) ? fw0[(4 * q4 + jj) >> 1] : fw1[(4 * q4 + jj - 8) >> 1];
                const float x = (jj & 1) ? bfhi(wf) : bflo(wf);
                const float ex = fexp(-fmaxf(x, -80.0f)), sg = __builtin_amdgcn_rcpf(1.0f + ex);
                const float f = lb + (1.0f - lb) * sg;
                lfv[jj] = flog2(f) * 0.6931471805599453f;
                kk[4 * q4 + jj] = (1.0f - lb) * (ex * sg);
            }
            *(LAS f32x4*)(G + m * 128 + d0 + 4 * q4) = lfv;
        }
        __syncthreads();
        {
            const int d = tid & 127, seg = tid >> 7; float v[16]; float run = 0.f;
#pragma unroll
            for (int i = 0; i < 16; ++i) { run += G[(16 * seg + i) * 128 + d]; v[i] = run; }
#pragma unroll
            for (int i = 0; i < 16; ++i) G[(16 * seg + i) * 128 + d] = v[i];
            __syncthreads();
            float pre = 0.f;
#pragma unroll
            for (int s2 = 0; s2 < 3; ++s2) { const float t = G[(16 * s2 + 15) * 128 + d]; pre += (s2 < seg) ? t : 0.f; }
            __syncthreads();
            if (seg > 0) {
#pragma unroll
                for (int i = 0; i < 16; ++i) G[(16 * seg + i) * 128 + d] = v[i] + pre;
            }
        }
        __syncthreads();
        const u32x4 qw0 = *(const u32x4*)(zr + 8 * 512), qw1 = *(const u32x4*)(zr + 8 * 512 + 8);
        const u32x4 vw0 = *(const u32x4*)(zr + 10 * 512), vw1 = *(const u32x4*)(zr + 10 * 512 + 8);
        float qt[16], qi[16], kt[16], ks[16];
#pragma unroll
        for (int jj = 0; jj < 16; ++jj) {
            const unsigned wq = (jj < 8) ? qw0[jj >> 1] : qw1[(jj - 8) >> 1];
            const float qraw = (jj & 1) ? bfhi(wq) : bflo(wq);
            const float qs = qraw * sigmoidf_(qraw);
            const float g = G[m * 128 + d0 + jj], gm = G[31 * 128 + d0 + jj], gl = G[63 * 128 + d0 + jj];
            if (MODE & 2) { qt[jj] = qs * fexp(g - gm); qi[jj] = qs * fexp(g); kt[jj] = kk[jj] * fexp(gm - g); } else { qt[jj] = 0.f; qi[jj] = 0.f; kt[jj] = 0.f; }
            ks[jj] = (MODE & 1) ? kk[jj] * fexp(gl - g) : 0.f;
        }
        const unsigned c1 = 2u * (unsigned)(tid & 7);
#define LA_ST2(T, ST, AR) do { u32x4 p_; p_[0] = pk2(AR[0], AR[1]); p_[1] = pk2(AR[2], AR[3]); p_[2] = pk2(AR[4], AR[5]); p_[3] = pk2(AR[6], AR[7]); *(LAS u32x4*)((T) + (ST) * m + 16u * c1) = p_; \
            u32x4 r_; r_[0] = pk2(AR[8], AR[9]); r_[1] = pk2(AR[10], AR[11]); r_[2] = pk2(AR[12], AR[13]); r_[3] = pk2(AR[14], AR[15]); *(LAS u32x4*)((T) + (ST) * m + 16u * c1 + 16u) = r_; } while (0)
        if (MODE & 2) { LA_ST2(QT, RS, qt); LA_ST2(QI, RS, qi); LA_ST2(KT, RS, kt); }
        if (MODE & 1) { LA_ST2(KS, TRS, ks); }
        *(LAS u32x4*)(VV + TRS * m + 16u * c1) = vw0; *(LAS u32x4*)(VV + TRS * m + 16u * c1 + 16u) = vw1;
        if ((MODE == 1) && tid < 128) st_wt(a.hdec + tid, fexp(G[63 * 128 + tid]));
    }
    const bool qpub = a.pub_prev && !pubdone;
    if (qpub) asm volatile("s_waitcnt vmcnt(0)" ::: "memory");
    TrItem cvt; f32x4 cvv[16];
    const bool cvreq = (MODE != 3) && a.cv_wi >= 0;
    const bool cvon = conv_list_setup(cvt, cvx, a.layer, cvreq ? a.cv_wi + w : -1, lane);
    if (cvreq) tr_load(cvt, cvv); else { for (int i = 0; i < 16; ++i) cvv[i] = (f32x4){0.f, 0.f, 0.f, 0.f}; }
    __syncthreads();
    if (qpub && tid == 0) __hip_atomic_fetch_add(a.pub_prev, 1u, __ATOMIC_RELAXED, __HIP_MEMORY_SCOPE_AGENT);
    float upd[2][16];
    if (MODE == 3) {
#pragma unroll
        for (int i = 0; i < 2; ++i) { const int tt = 2 * w + i, di = tt >> 2, ei = tt & 3;
#pragma unroll
            for (int g = 0; g < 16; ++g) upd[i][g] = a.Sprev[(32 * di + crow(g, h)) * 128 + 32 * ei + r]; }
        const float* sp0 = a.Sprev + (8 * h) * 128 + 32 * (w & 3) + r;
#pragma unroll
        for (int s = 0; s < 8; ++s)
#pragma unroll
            for (int j = 0; j < 8; ++j) sv[s][j] = sp0[(16 * s + j) * 128];
    }
    if (MODE & 1) {
#pragma unroll
        for (int i = 0; i < 2; ++i) {
            const int tt = 2 * w + i, di = tt >> 2, ei = tt & 3;
            f32x16 acc = zero16();
            if (MODE == 1) {
#pragma unroll
                for (int s = 0; s < 4; ++s) acc = MFMA32(tr8(VV, 16 * s + 8 * h, 16 * s + 8 * h + 4, ei, lane), tr8(KS, 16 * s + 8 * h, 16 * s + 8 * h + 4, di, lane), acc);
                const bool odd = (r & 1) != 0;
#pragma unroll
                for (int g2 = 0; g2 < 8; ++g2) {
                    const float m0 = acc[2 * g2], m1 = acc[2 * g2 + 1];
                    const float rv = __shfl_xor(odd ? m0 : m1, 1);
                    const unsigned word = odd ? pk2(rv, m1) : pk2(m0, rv);
                    const int e = 32 * ei + crow(2 * g2, h) + (odd ? 1 : 0);
                    st_wt32((unsigned*)(a.dSout + e * 128 + 32 * di + (r & ~1)), word);
                }
            } else {
#pragma unroll
                for (int s = 0; s < 4; ++s) acc = MFMA32(tr8(KS, 16 * s + 8 * h, 16 * s + 8 * h + 4, di, lane), tr8(VV, 16 * s + 8 * h, 16 * s + 8 * h + 4, ei, lane), acc);
#pragma unroll
                for (int g = 0; g < 16; ++g) { const int d = 32 * di + crow(g, h); const float dec = (MIXER == 0) ? decay_s : fexp(G[63 * 128 + d]);
                    a.Sout[d * 128 + 32 * ei + r] = dec * upd[i][g] + acc[g]; }
            }
        }
    }
    if (MODE & 2) {
        const int li = w >> 2, ei = w & 3;
        f32x16 O = zero16();
#pragma unroll
        for (int s = 0; s < 8; ++s) {
            bf16x8 bop;
            if (MODE == 2) { u32x4 bw; bw.x = (unsigned)svq[s][0]; bw.y = (unsigned)(svq[s][0] >> 32); bw.z = (unsigned)svq[s][1]; bw.w = (unsigned)(svq[s][1] >> 32); bop = __builtin_bit_cast(bf16x8, bw); }
            else bop = pack8(sv[s][0], sv[s][1], sv[s][2], sv[s][3], sv[s][4], sv[s][5], sv[s][6], sv[s][7]);
            O = MFMA32(ld_row(QI, 32 * li + r, s, h), bop, O);
        }
        for (int mi = 0; mi <= li; ++mi) {
            f32x16 X = zero16();
#pragma unroll
            for (int s = 0; s < 8; ++s) X = MFMA32(ld_row(KT, 32 * mi + r, s, h), ld_row(QT, 32 * li + r, s, h), X);
            if (mi == li) {
#pragma unroll
                for (int g = 0; g < 16; ++g) X[g] = (crow(g, h) <= r) ? X[g] : 0.f;
            }
            const bf16x8 pa0 = pack8(X[0], X[1], X[2], X[3], X[4], X[5], X[6], X[7]), pa1 = pack8(X[8], X[9], X[10], X[11], X[12], X[13], X[14], X[15]);
            O = MFMA32(pa0, tr8(VV, 32 * mi + 4 * h, 32 * mi + 8 + 4 * h, ei, lane), O);
            O = MFMA32(pa1, tr8(VV, 32 * mi + 16 + 4 * h, 32 * mi + 24 + 4 * h, ei, lane), O);
        }
        __syncthreads();
#pragma unroll
        for (int g = 0; g < 16; ++g) G[(32 * li + crow(g, h)) * 128 + 32 * ei + r] = O[g];
        __syncthreads();
        const int l = tid >> 3, e0 = 16 * (tid & 7);
        float o[16]; float ss = 0.f;
#pragma unroll
        for (int q4 = 0; q4 < 4; ++q4) { const f32x4 t = *(LAS const f32x4*)(G + l * 128 + e0 + 4 * q4); o[4 * q4] = t[0]; o[4 * q4 + 1] = t[1]; o[4 * q4 + 2] = t[2]; o[4 * q4 + 3] = t[3];
            ss += (t[0] * t[0] + t[1] * t[1]) + (t[2] * t[2] + t[3] * t[3]); }
        ss += __shfl_xor(ss, 1); ss += __shfl_xor(ss, 2); ss += __shfl_xor(ss, 4);
        const float rstd = __builtin_amdgcn_rsqf(ss * (1.0f / 128.0f) + EPS);
        float y[16];
#pragma unroll
        for (int jj = 0; jj < 16; ++jj) {
            const unsigned wg = (jj < 8) ? gw0[jj >> 1] : gw1[(jj - 8) >> 1];
            const float gt = (jj & 1) ? bfhi(wg) : bflo(wg);
            const float sg = sigmoidf_(gt);
            const float gate = (MIXER == 0) ? gt * sg : sg;
            y[jj] = o[jj] * rstd * ngv[jj >> 2][jj & 3] * gate;
        }
        u32x4 p0, p1; p0.x = pk2(y[0], y[1]); p0.y = pk2(y[2], y[3]); p0.z = pk2(y[4], y[5]); p0.w = pk2(y[6], y[7]);
        p1.x = pk2(y[8], y[9]); p1.y = pk2(y[10], y[11]); p1.z = pk2(y[12], y[13]); p1.w = pk2(y[14], y[15]);
        bf16* mo = a.mixo + (size_t)l * 2048 + e0;
        *(u32x4*)(mo) = p0; *(u32x4*)(mo + 8) = p1;
    }
    if (MODE != 3 && cvon) tr_store(cvt, cvv);
#undef LA_ST
#undef LA_ST2
}
template <int WIN>
DI void pool_win(const float (&u)[31], LAS unsigned char* P, const int seg, const int c, const bool prompt, const int row0) {
#pragma unroll
    for (int k = 0; k < 16; ++k) {
        float s = 0.f;
#pragma unroll
        for (int j = 0; j < WIN; ++j) s += u[k + 15 - j];
        const int t = 16 * seg + k, pos = prompt ? (row0 + t) : (PAST + t);
        const float cnt = (float)((pos + 1 < WIN) ? pos + 1 : WIN);
        const float p = s / cnt - u[k + 15];
        *(LAS unsigned short*)(P + RS * t + 2 * c) = (unsigned short)(pk2(p, 0.f) & 0xffffu);
    }
}
DI void pool_item(LAS unsigned char* lds, const bf16* z, const float* state_pool_l, const bf16* pwt_l, bf16* mix, const int ti, const int g, const ConvCtx& cvx, const int cv_l, const int cv_wi, const int tid_in) {
    int tid = tid_in; asm volatile("" : "+v"(tid));
    const int lane = tid & 63, w = __builtin_amdgcn_readfirstlane(tid >> 6), r = lane & 31, h = lane >> 5;
    LAS float* U = (LAS float*)lds;
    LAS unsigned char* P = lds + 49152;
    const bool prompt = ti < 128; const int row0 = prompt ? 64 * ti : 8192 + 64 * (ti - 128);
    TrItem cvt; f32x4 cvv[16];
    const bool cvon = conv_list_setup(cvt, cvx, cv_l, cv_wi >= 0 ? cv_wi + w : -1, lane);
    if (cv_wi >= 0) tr_load(cvt, cvv); else { for (int i = 0; i < 16; ++i) cvv[i] = (f32x4){0.f, 0.f, 0.f, 0.f}; }
    for (int n = tid; n < 79 * 16; n += 512) {
        const int j = n >> 4, ch = n & 15; float v[8];
        const int trow = row0 + j - 15;
        if (j >= 15 || (prompt && trow >= 0)) {
            const u32x4 t = *(const u32x4*)(z + (size_t)trow * 6144 + 7 * 512 + 128 * g + 8 * ch);
            v[0] = bflo(t.x); v[1] = bfhi(t.x); v[2] = bflo(t.y); v[3] = bfhi(t.y); v[4] = bflo(t.z); v[5] = bfhi(t.z); v[6] = bflo(t.w); v[7] = bfhi(t.w);
        } else if (!prompt) {
            const float* sp = state_pool_l + ((size_t)(ti - 128) * 15 + j) * 512 + 128 * g + 8 * ch;
            const f32x4 a = *(const f32x4*)sp, b = *(const f32x4*)(sp + 4);
            v[0] = a[0]; v[1] = a[1]; v[2] = a[2]; v[3] = a[3]; v[4] = b[0]; v[5] = b[1]; v[6] = b[2]; v[7] = b[3];
        } else {
#pragma unroll
            for (int i = 0; i < 8; ++i) v[i] = 0.f;
        }
        *(LAS f32x4*)(U + j * 128 + 8 * ch) = (f32x4){v[0], v[1], v[2], v[3]}; *(LAS f32x4*)(U + j * 128 + 8 * ch + 4) = (f32x4){v[4], v[5], v[6], v[7]};
    }
    __syncthreads();
    {   const int c = tid & 127, seg = tid >> 7;
        float u[31];
#pragma unroll
        for (int i = 0; i < 31; ++i) u[i] = U[(16 * seg + i) * 128 + c];
        switch (g) {
            case 0: pool_win<2>(u, P, seg, c, prompt, row0); break;
            case 1: pool_win<4>(u, P, seg, c, prompt, row0); break;
            case 2: pool_win<8>(u, P, seg, c, prompt, row0); break;
            default: pool_win<16>(u, P, seg, c, prompt, row0); break;
        }
    }
    __syncthreads();
    const int ti2 = w >> 2, di = w & 3;
    f32x16 acc = zero16();
    const bf16* wb = pwt_l + ((size_t)g * 128 + 32 * di + r) * 128 + 8 * h;
#pragma unroll
    for (int s = 0; s < 8; ++s) acc = MFMA32(ld_row(P, 32 * ti2 + r, s, h), *(const bf16x8*)(wb + 16 * s), acc);
#pragma unroll
    for (int i = 0; i < 16; ++i) mix[(size_t)(row0 + 32 * ti2 + crow(i, h)) * 2048 + 1024 + 128 * g + 32 * di + r] = (unsigned short)(pk2(acc[i], 0.f) & 0xffffu);
    if (cvon) tr_store(cvt, cvv);
}

DI float wave_sum(float v) {
#pragma unroll
    for (int o = 1; o < 64; o <<= 1) v += __shfl_xor(v, o);
    return v;
}
constexpr int NWAVES_ = 8;
DI void splitk_fixup(bf16* XB, float* ssq, const bf16* slab, const pg8::SplitOrder& S, const int bx, const int tid_in) {
    int tid = tid_in; asm volatile("" : "+v"(tid));
    const int lane = tid & 63, wave = tid >> 6;
    for (int it0 = (bx * NWAVES_ + wave) * 4; it0 < 64 * 256; it0 += 256 * NWAVES_ * 4) {
        u32x2 rr[4], p0[4], p1[4], p2[4], p3[4]; size_t offs[4]; int rows[4], pns[4];
#pragma unroll
        for (int q = 0; q < 4; ++q) {
            const int it = it0 + q, s = it >> 8, r = it & 255;
            pg8::Unit u; S.tile_of(256 + s, u);
            const int row = u.pm * 256 + r, col = u.pn * 256 + 4 * lane;
            const size_t off = (size_t)row * 2048 + col; offs[q] = off; rows[q] = row; pns[q] = u.pn;
            const bf16* sp = slab + ((size_t)(s * 4) * 256 + r) * 256 + 4 * lane;
            rr[q] = *(const u32x2*)(XB + off); p0[q] = *(const u32x2*)(sp); p1[q] = *(const u32x2*)(sp + 65536); p2[q] = *(const u32x2*)(sp + 2 * 65536); p3[q] = *(const u32x2*)(sp + 3 * 65536);
        }
#pragma unroll
        for (int q = 0; q < 4; ++q) {
            const f32x4 rf = {bflo(rr[q].x), bfhi(rr[q].x), bflo(rr[q].y), bfhi(rr[q].y)};
#define F4_(v) ((f32x4){bflo((v).x), bfhi((v).x), bflo((v).y), bfhi((v).y)})
            const f32x4 o = rf + (((F4_(p0[q]) + F4_(p1[q])) + F4_(p2[q])) + F4_(p3[q]));
#undef F4_
            u32x2 w; w.x = pk2(o[0], o[1]); w.y = pk2(o[2], o[3]); *(u32x2*)(XB + offs[q]) = w;
            float qq = (o[0] * o[0] + o[1] * o[1]) + (o[2] * o[2] + o[3] * o[3]);
            qq += __shfl_xor(qq, 1); qq += __shfl_xor(qq, 2); qq += __shfl_xor(qq, 4); qq += __shfl_xor(qq, 8);
            if ((lane & 15) == 0) ssq[(size_t)rows[q] * 32 + pns[q] * 4 + (lane >> 4)] = qq;
        }
    }
}
constexpr int NWAVES = 8;
#ifndef G1_CV
#define G1_CV 0
#endif
#ifndef G1_WGM
#define G1_WGM 8
#endif
#ifndef G3_WGM
#define G3_WGM 8
#endif
#ifndef REP_M1_MASK
#define REP_M1_MASK 63
#endif
#define M1_RUN(bit) (rep == 0 || (REP_M1_MASK & (bit)))
#ifndef GEMM_ALIGN
#define GEMM_ALIGN true
#endif
#ifndef GEMM_SP2
#define GEMM_SP2 true
#endif
#ifndef REP_P0
#define REP_P0 1
#endif
#ifndef REP_G1
#define REP_G1 1
#endif
#ifndef REP_M1
#define REP_M1 1
#endif
#ifndef REP_M3
#define REP_M3 1
#endif
#ifndef REP_G3
#define REP_G3 1
#endif
constexpr int NPHASE = 2 + 7 * NL;
struct Args { const float* in[19]; float* out; unsigned char* ws; int ph_lo, ph_hi; };
static_assert(sizeof(Args) == 19 * 8 + 8 + 8 + 8, "Args has no padding holes");

__global__ void __launch_bounds__(NWAVES * 64, 2) fwd(Args args) {
    extern __shared__ __attribute__((aligned(16))) unsigned char lds_raw[];
    LAS unsigned char* lds = (LAS unsigned char*)lds_raw;
    volatile LAS unsigned* MISC = (volatile LAS unsigned*)(lds + LDS_CTL_OFF);
    const int tid0 = threadIdx.x;
#define PHASE_TID() int tid = tid0; asm volatile("" : "+v"(tid)); const int lane = tid & 63, wave = __builtin_amdgcn_readfirstlane(tid >> 6); (void)lane; (void)wave
    const int G = gridDim.x, bx = blockIdx.x;
    unsigned char* ws = args.ws;
    unsigned* ctl = (unsigned*)(ws + WS_CTL);
    float* ssq = (float*)(ws + WS_SSQ);
    bf16* WinT = (bf16*)(ws + WS_WIN); bf16* WoutT = (bf16*)(ws + WS_WOUT); bf16* WupT = (bf16*)(ws + WS_WUP); bf16* WdnT = (bf16*)(ws + WS_WDN);
    bf16* PoolWT = (bf16*)(ws + WS_POOLW); bf16* XB = (bf16*)(ws + WS_XB); bf16* Z = (bf16*)(ws + WS_Z);
    bf16* MIX = (bf16*)(ws + WS_MIX); bf16* UU = (bf16*)(ws + WS_U); bf16* DSB = (bf16*)(ws + WS_DS); float* HDEC = (float*)(ws + WS_HDEC); bf16* SLAB = (bf16*)(ws + WS_SLAB); float* LB = (float*)(ws + WS_LB); float* ONES = (float*)(ws + WS_LB + 65536);
    const float* x_prompt = args.in[0]; const float* x_sample = args.in[1]; const float* state_ret = args.in[2]; const float* cache_k = args.in[3]; const float* cache_v = args.in[4];
    const float* state_pool = args.in[5]; const float* state_hgrn = args.in[6]; const float* norm1_g = args.in[7]; const float* w_in = args.in[8]; const float* ret_norm_g = args.in[9];
    const float* pool_w = args.in[10]; const float* pool_scale = args.in[11]; const float* hg_lb = args.in[12]; const float* hg_norm_g = args.in[13]; const float* w_out = args.in[14];
    const float* norm2_g = args.in[15]; const float* w_up = args.in[16]; const float* w_down = args.in[17]; const float* final_g = args.in[18];
    float* out = args.out;
    const ConvCtx cvx{w_in, w_out, w_up, w_down, norm1_g, norm2_g, ONES, WinT, WoutT, WupT, WdnT};

    for (int u = tid0; u < (LDS_BYTES - LDS_CTL_OFF) / 4; u += NWAVES * 64) ((LAS unsigned*)(lds + LDS_CTL_OFF))[u] = 0u;
    __syncthreads();
#ifdef PH_PROBE
    if (tid0 == 0) MISC[64 + 31] = (unsigned)__builtin_amdgcn_s_memrealtime();
#endif
#if MK_PER_PHASE
#define GRID_BAR() do { } while (0)
#else
    XcdBarrier bar = xcd_barrier_post(ctl + CW_BAR, MISC + 8);
#ifndef REP_BAR
#define REP_BAR 1
#endif
#define GRID_BAR() do { for (int rb_ = 0; rb_ < REP_BAR; ++rb_) xcd_barrier(bar); } while (0)
#endif
    volatile LAS int* wq_slot = (volatile LAS int*)(MISC + 16);
    const int lo = args.ph_lo, hi = args.ph_hi;
#define IN(k) (lo <= (k) && (k) < hi)
#ifdef PH_PROBE
#define SEAM(k) do { if (IN(k) && IN((k) + 1)) GRID_BAR(); if (tid0 == 0) MISC[64 + (k)] = (unsigned)__builtin_amdgcn_s_memrealtime(); } while (0)
#else
#define SEAM(k) do { if (IN(k) && IN((k) + 1)) GRID_BAR(); } while (0)
#endif

    if (IN(0)) for (int rep = 0; rep < REP_P0; ++rep) {
        PHASE_TID();
        const int gw = bx * NWAVES + wave, NGW = G * NWAVES;
        for (int it = 2 * gw; it < CV_IN; it += 2 * NGW) conv_wave_pair(w_in, w_out, w_up, w_down, norm1_g, norm2_g, ONES, WinT, WoutT, WupT, WdnT, 0, it, 0, it + 1, lane);
        for (int i = bx * 512 + tid; i < NL * 4 * 128 * 128; i += G * 512) {
            const int c = i & 127, d = (i >> 7) & 127, g = (i >> 14) & 3, l = i >> 16;
            PoolWT[i] = (unsigned short)(pk2(pool_w[(((size_t)l * 4 + g) * 128 + c) * 128 + d] * pool_scale[l * 512 + 128 * g + d], 0.f) & 0xffffu);
        }
        for (int i = bx * 512 + tid; i < DFF; i += G * 512) ONES[i] = 1.0f;
        for (int i = bx * 512 + tid; i < 512; i += G * 512) {
            const float b0 = hg_lb[i], b1 = hg_lb[512 + i], b2 = hg_lb[1024 + i], b3 = hg_lb[1536 + i];
            const float mx = fmaxf(fmaxf(b0, b1), fmaxf(b2, b3));
            const float e0 = fexp(b0 - mx), e1 = fexp(b1 - mx), e2 = fexp(b2 - mx), e3 = fexp(b3 - mx), den = (e0 + e1) + (e2 + e3);
            LB[i] = 0.f; LB[512 + i] = e1 / den; LB[1024 + i] = (e1 + e2) / den; LB[1536 + i] = ((e1 + e2) + e3) / den;
        }
        for (int m = gw; m < MR; m += NGW) {
            const float* xr = (m < TP) ? x_prompt + (size_t)m * DM : x_sample + (size_t)(m - TP) * DM;
            float s = 0.f; f32x4 xv[8];
#pragma unroll
            for (int j = 0; j < 8; ++j) xv[j] = *(const f32x4*)(xr + 4 * lane + 256 * j);
#pragma unroll
            for (int j = 0; j < 8; ++j) { const f32x4 v = xv[j]; s += (v[0] * v[0] + v[1] * v[1]) + (v[2] * v[2] + v[3] * v[3]);
                u32x2 p; p.x = pk2(v[0], v[1]); p.y = pk2(v[2], v[3]); *(u32x2*)(XB + (size_t)m * DM + 4 * lane + 256 * j) = p; }
            s = wave_sum(s);
            if (lane < 32) ssq[(size_t)m * 32 + lane] = (lane == 0) ? s : 0.f;
        }
    }
    SEAM(0);

    for (int l = 0; l < NL; ++l) {
        const int pb = 1 + 7 * l;
        int bxl = bx; asm volatile("" : "+s"(bxl));
        float* ssq1 = ssq + (size_t)(2 * l) * MR * 32; float* ssq2 = ssq + (size_t)(2 * l + 1) * MR * 32; float* ssq3 = ssq + (size_t)(2 * l + 2) * MR * 32;
        if (IN(pb)) for (int rep = 0; rep < REP_G1; ++rep) {
            pg8::Gemm g{XB, WinT + (size_t)l * DIN * DM, MR, DIN, DM}; pg8::StaticOrder S; S.init(MR, DIN, G, bxl, DM, G1_WGM);
            pg8::EpiIn E{Z, ssq1,
                         out + O_POOLP + (size_t)l * 15 * 512, out + O_POOLS + (size_t)l * NB * 15 * 512};
            pg8::gemm_phase<pg8::EpiIn, pg8::StaticOrder, GEMM_ALIGN, GEMM_SP2>(lds, g, S, E);
            if (G == 256 && bxl >= 192) {
                PHASE_TID();
                const int w0 = ((bxl - 192) * NWAVES + wave) * (G1_CV / 512);
                for (int i = 0; i < G1_CV / 512; i += 2) {
                    TrItem t0, t1; f32x4 v0[16], v1[16];
                    const bool on0 = conv_list_setup(t0, cvx, l, w0 + i, lane); tr_load(t0, v0);
                    const bool on1 = conv_list_setup(t1, cvx, l, w0 + i + 1, lane); tr_load(t1, v1);
                    if (on0) tr_store(t0, v0);
                    if (on1) tr_store(t1, v1);
                }
            }
        }
        SEAM(pb);
        if (IN(pb + 1)) {
            PHASE_TID();
            unsigned* qctr = ctl + CW_Q + 64 * (2 * l);
            unsigned* dep = ctl + CW_DEP + (l * 16) * 64; unsigned* tmo = ctl;
            const int wq_base = (G == 256) ? 256 : 0;
            int wq_pre = (G == 256) ? ((tid == 0) ? bxl : 0) : wq_claim(qctr), wq_par = 0;
            unsigned* pend = nullptr;
            bool m2_chk = false;
            unsigned seen = 0u;
            for (;;) {
#ifdef PH_PROBE
                if (l == 1 && tid == 0) { const int q_ = wq_pre; const int k_ = q_ == 256 ? 0 : q_ == 1280 ? 1 : q_ == 1408 ? 2 : q_ == 1664 ? 3 : q_ == 2304 ? 4 : q_ == 3328 ? 5 : -1;
                    if (k_ >= 0) __hip_atomic_store(ctl + 24576 + k_, (unsigned)__builtin_amdgcn_s_memrealtime(), __ATOMIC_RELAXED, __HIP_MEMORY_SCOPE_AGENT); }
#endif
                const int it = wq_next(qctr, wq_slot, wq_pre, wq_par, wq_base);
                if (it >= 3328) break;
                if ((it >= 256 && it < 1536) || it >= 2304) {
                    LaArgs a; int mixer; a.tmo = tmo; a.dep_done = nullptr; a.dep_need = nullptr; a.cv_wi = -1; a.pub_prev = pend;
                    if (it < 1280) { const int k = it - 256; mixer = k >> 9; const int rem = k & 511, hh = rem >> 7, c = rem & 127;
                        a.z = Z + (size_t)(64 * c) * DIN; a.h = hh; a.pos0 = 64 * c; a.mode = 1; a.prompt = 1;
                        a.Sprev = nullptr; a.SpT = nullptr; a.dSout = DSB + ((size_t)(mixer * 4 + hh) * 128 + c) * 16384; a.Sout = nullptr; a.hdec = HDEC + ((size_t)hh * 128 + c) * 128;
                        a.mixo = nullptr; a.cv_wi = (G1_CV + 3072 + 8 * k < 12288) ? G1_CV + 3072 + 8 * k : -1; a.dep_done = dep + (mixer * 4 + hh) * 64;
                    } else if (it < 1536) { const int k = it - 1280; mixer = k >> 7; const int rem = k & 127, b = rem >> 2, hh = rem & 3;
                        a.z = Z + (size_t)(TP + 64 * b) * DIN; a.h = hh; a.pos0 = PAST; a.mode = 3; a.prompt = 0;
                        a.Sprev = (mixer == 0 ? state_ret : state_hgrn) + ((size_t)(l * NB + b) * 4 + hh) * 16384; a.SpT = nullptr; a.dSout = nullptr;
                        a.Sout = out + (mixer == 0 ? O_RETS : O_HGS) + ((size_t)(l * NB + b) * 4 + hh) * 16384; a.hdec = nullptr;
                        a.mixo = MIX + (size_t)(TP + 64 * b) * DM + (mixer == 0 ? 0 : 1536) + hh * 128;
                    } else { const int k = it - 2304; mixer = k >> 9; const int rem = k & 511, hh = rem >> 7, c = rem & 127;
                        if (!m2_chk) {
                            m2_chk = true;
                            if (tid == 0) { unsigned cv_[8], m_ = 0u;
#pragma unroll
                                for (int j = 0; j < 8; ++j) cv_[j] = __hip_atomic_load(dep + (8 + j) * 64, __ATOMIC_RELAXED, __HIP_MEMORY_SCOPE_AGENT);
#pragma unroll
                                for (int j = 0; j < 8; ++j) m_ |= (cv_[j] >= 16u) ? (1u << j) : 0u;
                                MISC[24] = m_; }
                            __builtin_amdgcn_fence(__ATOMIC_ACQUIRE, "wavefront");
                            __syncthreads();
                            seen |= MISC[24];
                        }
                        a.z = Z + (size_t)(64 * c) * DIN; a.h = hh; a.pos0 = 64 * c; a.mode = 2; a.prompt = 1;
                        a.Sprev = nullptr; a.SpT = DSB + ((size_t)(mixer * 4 + hh) * 128 + c) * 16384; a.dSout = nullptr; a.Sout = nullptr; a.hdec = nullptr;
                        a.mixo = MIX + (size_t)(64 * c) * DM + (mixer == 0 ? 0 : 1536) + hh * 128;
                        const int mh = mixer * 4 + hh; a.dep_need = ((seen >> mh) & 1u) ? nullptr : dep + (8 + mh) * 64; seen |= 1u << mh;
                    }
                    a.ng = (mixer == 0 ? ret_norm_g : hg_norm_g) + l * 512 + a.h * 128; a.lbsrc = LB + l * 512; a.layer = l;
                    if (it < 1280) { if (mixer == 0) la_item<0, 1>(lds, a, cvx, tid); else la_item<1, 1>(lds, a, cvx, tid); }
                    else if (it < 1536) { if (mixer == 0) la_item<0, 3>(lds, a, cvx, tid); else la_item<1, 3>(lds, a, cvx, tid); }
                    else { if (mixer == 0) la_item<0, 2>(lds, a, cvx, tid); else la_item<1, 2>(lds, a, cvx, tid); }
                    pend = a.dep_done;
                } else if (it < 256) {
                    if (pend) { dep_publish(pend); pend = nullptr; }
                    const int k = it; SbArgs a;
                    if (k < 128) { const int b = k >> 2, hh = k & 3; const size_t zr = (size_t)(TP + 64 * b) * DIN;
                        a.zq = Z + zr + 4 * 512 + hh * 128; a.zk = Z + zr + 5 * 512 + hh * 128; a.zv = Z + zr + 6 * 512 + hh * 128;
                        a.kc = cache_k + ((size_t)(l * NB + b) * PAST) * 512 + hh * 128; a.vc = cache_v + ((size_t)(l * NB + b) * PAST) * 512 + hh * 128;
                        a.nf32 = 64; a.t_hi = 64; a.qpos0 = PAST; a.nqw = 2; a.mixo = MIX + (size_t)(TP + 64 * b) * DM + 512 + hh * 128;
                        a.ok = out + O_SBKS + ((size_t)l * 2048 + 64 * b) * 512 + hh * 128; a.ovd = (int)(O_SBVS - O_SBKS); a.own_lo = 64;
                    } else { const int k2 = k - 128, sl_ = k2 >> 3, qi = 31 - 4 * (k2 & 7) - (sl_ >> 2), hh = sl_ & 3;
                        a.zq = Z + (size_t)(256 * qi) * DIN + 4 * 512 + hh * 128; a.zk = Z + 5 * 512 + hh * 128; a.zv = Z + 6 * 512 + hh * 128;
                        a.kc = cache_k; a.vc = cache_v; a.nf32 = 0; a.t_hi = 4 * qi + 3; a.qpos0 = 256 * qi; a.nqw = 8; a.mixo = MIX + (size_t)(256 * qi) * DM + 512 + hh * 128;
                        a.ok = out + O_SBKP + (size_t)l * TP * 512 + hh * 128; a.ovd = (int)(O_SBVP - O_SBKP); a.own_lo = 4 * qi;
                    }
                    sb_item(lds, a, cvx, l, (k < 128) ? G1_CV + 24 * k : -1, tid);
                } else if (it < 1664) {
                    int tq = tid; asm volatile("" : "+v"(tq));
                    const int s = it - 1536, mh = s >> 4, mixer = mh >> 2, hh = mh & 3, pidx = (s & 15) * 512 + tq, d = (2 * pidx) & 127, e = (2 * pidx) >> 7;
                    if (pend) { dep_publish(pend); pend = nullptr; }
                    dep_wait_sc1(dep + mh * 64, 128u, tmo);
                    unsigned* base = (unsigned*)DSB + (size_t)mh * 128 * 8192 + pidx;
                    const float dret = fexp2(64.0f * flog2(1.0f - fexp2(-5.0f - (float)hh)));
                    LAS float* H = (LAS float*)lds;
                    if (mixer == 1) {
                        const unsigned long long* hsrc = (const unsigned long long*)(HDEC + (size_t)hh * 16384);
#pragma unroll
                        for (int i = 0; i < 16; ++i) { const unsigned long long v = ld_wt64(hsrc + tq + 512 * i); *(LAS unsigned long long*)(H + 2 * (tq + 512 * i)) = v; }
                        __syncthreads();
                    }
                    float st0 = 0.f, st1 = 0.f;
                    for (int c0 = 0; c0 < 128; c0 += 64) {
                        unsigned t[64];
#pragma unroll
                        for (int c = 0; c < 64; ++c) t[c] = ld_wt32(base + (size_t)(c0 + c) * 8192);
                        if (mixer == 0) {
#pragma unroll
                            for (int c = 0; c < 64; ++c) { st_wt32(base + (size_t)(c0 + c) * 8192, pk2(st0, st1)); st0 = dret * st0 + bflo(t[c]); st1 = dret * st1 + bfhi(t[c]); }
                        } else {
#pragma unroll
                            for (int c = 0; c < 64; ++c) { st_wt32(base + (size_t)(c0 + c) * 8192, pk2(st0, st1)); const float dc0 = H[(c0 + c) * 128 + d], dc1 = H[(c0 + c) * 128 + d + 1];
                                st0 = dc0 * st0 + bflo(t[c]); st1 = dc1 * st1 + bfhi(t[c]); }
                        }
                    }
                    float* fo = out + (mixer == 0 ? O_RETP : O_HGP) + ((size_t)l * 4 + hh) * 16384;
                    fo[d * 128 + e] = st0; fo[(d + 1) * 128 + e] = st1;
                    pend = dep + (8 + mh) * 64;
                } else {
                    const int k = it - 1664;
                    if (pend) { dep_publish(pend); pend = nullptr; }
                    pool_item(lds, Z, state_pool + (size_t)l * NB * 15 * 512, PoolWT + (size_t)l * 4 * 128 * 128, MIX, k >> 2, k & 3, cvx, l, (G1_CV + 11264 + 8 * k < 12288) ? G1_CV + 11264 + 8 * k : -1, tid);
                }
            }
            if (pend) dep_publish(pend);
        }
        SEAM(pb + 1);
        if (IN(pb + 4)) {
            pg8::Gemm g{MIX, WoutT + (size_t)l * DM * DM, MR, DM, DM};
            pg8::EpiRes E{XB, ssq2, SLAB, bxl >> 2};
            if (G == 256) { pg8::SplitOrder S; S.init(MR, DM, G, bxl, DM, 5); pg8::gemm_phase<pg8::EpiRes, pg8::SplitOrder, GEMM_ALIGN, GEMM_SP2>(lds, g, S, E);
                GRID_BAR(); splitk_fixup(XB, ssq2, SLAB, S, bxl, tid0); }
            else { pg8::StaticOrder S; S.init(MR, DM, G, bxl, DM); pg8::gemm_phase<pg8::EpiRes, pg8::StaticOrder, GEMM_ALIGN, GEMM_SP2>(lds, g, S, E); }
        }
        SEAM(pb + 4);
        if (IN(pb + 5)) for (int rep = 0; rep < REP_G3; ++rep) {
            if (rep) GRID_BAR();
            pg8::Gemm g{XB, WupT + (size_t)l * DFF * DM, MR, DFF, DM}; pg8::StaticOrder S; S.init(MR, DFF, G, bxl, DM, G3_WGM);
            pg8::EpiUp E{UU, ssq2, DFF};
            pg8::gemm_phase<pg8::EpiUp, pg8::StaticOrder, GEMM_ALIGN, GEMM_SP2>(lds, g, S, E);
        }
        SEAM(pb + 5);
        if (IN(pb + 6)) {
            pg8::Gemm g{UU, WdnT + (size_t)l * DM * DFF, MR, DM, DFF};
            pg8::EpiRes E{XB, ssq3, SLAB, bxl >> 2};
            if (G == 256) { pg8::SplitOrder S; S.init(MR, DM, G, bxl, DFF, 5); pg8::gemm_phase<pg8::EpiRes, pg8::SplitOrder, GEMM_ALIGN, GEMM_SP2>(lds, g, S, E);
                GRID_BAR(); splitk_fixup(XB, ssq3, SLAB, S, bxl, tid0); }
            else { pg8::StaticOrder S; S.init(MR, DM, G, bxl, DFF); pg8::gemm_phase<pg8::EpiRes, pg8::StaticOrder, GEMM_ALIGN, GEMM_SP2>(lds, g, S, E); }
        }
        SEAM(pb + 6);
    }
    if (IN(NPHASE - 1)) {
        PHASE_TID();
        const float* sf = ssq + (size_t)(2 * NL) * MR * 32;
        const int gw = bx * NWAVES + wave, NGW = G * NWAVES;
        for (int m = gw; m < MR; m += NGW) {
            const float sq = wave_sum(lane < 32 ? sf[(size_t)m * 32 + lane] : 0.f);
            const float rs = __builtin_amdgcn_rsqf(sq * (1.0f / 2048.0f) + EPS);
            const bf16* xr = XB + (size_t)m * DM; float* yr = out + O_Y + (size_t)m * DM;
            u32x4 xv[4];
#pragma unroll
            for (int j = 0; j < 4; ++j) xv[j] = *(const u32x4*)(xr + 8 * lane + 512 * j);
#pragma unroll
            for (int j = 0; j < 4; ++j) { const f32x4 g0 = *(const f32x4*)(final_g + 8 * lane + 512 * j), g1 = *(const f32x4*)(final_g + 8 * lane + 512 * j + 4);
                const f32x4 v0 = {bflo(xv[j].x), bfhi(xv[j].x), bflo(xv[j].y), bfhi(xv[j].y)}, v1 = {bflo(xv[j].z), bfhi(xv[j].z), bflo(xv[j].w), bfhi(xv[j].w)};
                *(f32x4*)(yr + 8 * lane + 512 * j) = v0 * rs * g0; *(f32x4*)(yr + 8 * lane + 512 * j + 4) = v1 * rs * g1; }
        }
    }
#ifdef PH_PROBE
    if (tid0 == 0) MISC[64 + 30] = (unsigned)__builtin_amdgcn_s_memrealtime();
    if (bx == 0 && tid0 == 0) {
#define PH_T(i) ((i) >= 100 ? __hip_atomic_load(ctl + 24576 + ((i) - 100), __ATOMIC_RELAXED, __HIP_MEMORY_SCOPE_AGENT) : (unsigned)MISC[64 + (i)])
        const unsigned d = PH_T(PH_B) - PH_T(PH_A);
        const unsigned long long t_end = __builtin_amdgcn_s_memrealtime() + (unsigned long long)d * PH_FACT;
        while (__builtin_amdgcn_s_memrealtime() < t_end) __builtin_amdgcn_s_sleep(20);
    }
#endif
#undef IN
#undef SEAM
#undef GRID_BAR
}

extern "C" void kernel_launch(void* const* d_in, const int* in_sizes, int n_in, void* d_out, int out_size, void* d_ws, size_t ws_size, hipStream_t stream) {
    static int grid = 0;
    if (grid == 0) {
        if (n_in != 19 || (size_t)out_size != O_END || ws_size < WS_END) { fprintf(stderr, "kernel_launch: unexpected shapes: n_in %d out %d ws %zu (need %zu, %zu)\n", n_in, out_size, ws_size, (size_t)O_END, (size_t)WS_END); grid = -1; return; }
        int dev = 0, cus = 0, per_cu = 0;
        if (hipGetDevice(&dev) != hipSuccess || hipDeviceGetAttribute(&cus, hipDeviceAttributeMultiprocessorCount, dev) != hipSuccess) { grid = -1; return; }
        if (hipFuncSetAttribute((const void*)fwd, hipFuncAttributeMaxDynamicSharedMemorySize, LDS_BYTES) != hipSuccess) { fprintf(stderr, "kernel_launch: hipFuncSetAttribute failed\n"); grid = -1; return; }
        if (hipOccupancyMaxActiveBlocksPerMultiprocessor(&per_cu, (const void*)fwd, NWAVES * 64, LDS_BYTES) != hipSuccess || per_cu < 1) fprintf(stderr, "kernel_launch: occupancy query reports %d\n", per_cu);
        (void)hipGetLastError();
        grid = cus;
    }
    if (grid < 0) return;
    if (hipMemsetAsync((char*)d_ws + WS_CTL, 0, CTL_ZERO_BYTES, stream) != hipSuccess) { fprintf(stderr, "kernel_launch: memset failed\n"); return; }
    Args a{};
    for (int i = 0; i < 19; ++i) a.in[i] = (const float*)d_in[i];
    a.out = (float*)d_out; a.ws = (unsigned char*)d_ws;
#if MK_PER_PHASE
    for (int p = 0; p < NPHASE; ++p) { a.ph_lo = p; a.ph_hi = p + 1; hipLaunchKernelGGL(fwd, dim3(grid), dim3(NWAVES * 64), LDS_BYTES, stream, a); }
#else
    a.ph_lo = 0; a.ph_hi = NPHASE;
    hipLaunchKernelGGL(fwd, dim3(grid), dim3(NWAVES * 64), LDS_BYTES, stream, a);
#endif
    const hipError_t le = hipPeekAtLastError();
    if (le != hipSuccess) fprintf(stderr, "kernel_launch: launch failed: %s\n", hipGetErrorName(le));
}
```
